# Optimizing an MI355X kernel written in HIP

```python
import jax, jax.numpy as jnp
from jax import lax
import numpy as np

D_MODEL = 1024
BATCH = 1
SEQ = 16384
DEPTH = 2
DEC_BATCH = 32
DEC_SEQ = 64
PAST_LEN = 1024

CHUNK = 64
D_CONV = D_MODEL // 2
CONV_W = 3
D_RWKV = D_MODEL // 2
HEAD_SIZE = 64
N_HEADS = D_RWKV // HEAD_SIZE
D_DECAY_LORA = 64
D_AAA_LORA = 64
D_GATE_LORA = 128
LN_X_EPS = 64e-5
D_FF = ((8 * D_MODEL // 3 + 255) // 256) * 256
RMS_EPS = 1e-6

OFF_CONV_X = 0
OFF_CONV_B = D_CONV
OFF_CONV_C = 2 * D_CONV
OFF_RWKV = 3 * D_CONV
RWKV_COLS = 3 * D_RWKV + D_DECAY_LORA + D_AAA_LORA + D_GATE_LORA
OFF_GATE = OFF_RWKV + RWKV_COLS
IN_COLS = OFF_GATE + 2 * D_MODEL
R_R = 0
R_K = D_RWKV
R_V = 2 * D_RWKV
R_W = 3 * D_RWKV
R_A = R_W + D_DECAY_LORA
R_G = R_A + D_AAA_LORA

kernel_name = "hybrid_conv_rwkv7_streaming_step"


def _rms_norm(x, g):
    xf = x.astype(jnp.float32)
    y = xf * lax.rsqrt(jnp.mean(xf * xf, axis=-1, keepdims=True) + RMS_EPS)
    return (y * g.astype(jnp.float32)).astype(x.dtype)


def _wkv_scan(s0, r, w, k, v, a, b):
    def step(s, inp):
        r_t, w_t, k_t, v_t, a_t, b_t = inp
        sa = jnp.einsum('bhij,bhj->bhi', s, a_t)
        s = s * w_t[:, :, None, :] + sa[..., None] * b_t[:, :, None, :] + v_t[..., None] * k_t[:, :, None, :]
        y = jnp.einsum('bhij,bhj->bhi', s, r_t)
        return s, y
    xs = tuple(jnp.moveaxis(t, 1, 0) for t in (r, w, k, v, a, b))
    s_fin, ys = lax.scan(step, s0, xs)
    return jnp.moveaxis(ys, 0, 1), s_fin


def _mixer(h, conv_state, shift_state, wkv_state, p):
    bsz, t_len, _ = h.shape
    proj = jnp.einsum('btd,dc->btc', h, p["w_in"])

    xin = proj[..., OFF_CONV_X:OFF_CONV_X + D_CONV]
    bg = proj[..., OFF_CONV_B:OFF_CONV_B + D_CONV]
    cg = proj[..., OFF_CONV_C:OFF_CONV_C + D_CONV]
    u = cg * xin
    u_pad = jnp.concatenate([conv_state.astype(u.dtype), u], axis=1)
    cw = p["conv_w"]
    y_conv = cw[0] * u_pad[:, 0:t_len] + cw[1] * u_pad[:, 1:t_len + 1] + cw[2] * u_pad[:, 2:t_len + 2]
    new_conv = u_pad[:, -(CONV_W - 1):]
    branch_a = jnp.einsum('btc,cd->btd', bg * y_conv, p["w_conv_out"])

    pr = proj[..., OFF_RWKV:OFF_RWKV + RWKV_COLS]
    prev = jnp.concatenate([shift_state.astype(pr.dtype)[:, None], pr[:, :-1]], axis=1)
    ps = pr + (prev - pr) * p["mu_shift"]
    new_shift = pr[:, -1]
    r = ps[..., R_R:R_R + D_RWKV]
    k = ps[..., R_K:R_K + D_RWKV]
    v = ps[..., R_V:R_V + D_RWKV]
    wl = ps[..., R_W:R_W + D_DECAY_LORA]
    al = ps[..., R_A:R_A + D_AAA_LORA]
    gl = ps[..., R_G:R_G + D_GATE_LORA]

    w_raw = (p["w_decay0"] + jnp.tanh(wl) @ p["w_decay2"]).astype(jnp.float32)
    w_raw = -jax.nn.softplus(-w_raw) - 0.5
    decay = jnp.exp(-jnp.exp(w_raw))
    a = jax.nn.sigmoid((p["a0"] + al @ p["a2"]).astype(jnp.float32))
    g = jax.nn.sigmoid(gl) @ p["g2"]

    hs = (bsz, t_len, N_HEADS, HEAD_SIZE)
    rf = r.astype(jnp.float32).reshape(hs)
    vf = v.astype(jnp.float32).reshape(hs)
    kf = k.astype(jnp.float32)
    kk = (kf * p["k_k"].astype(jnp.float32)).reshape(hs)
    kk = kk / jnp.maximum(jnp.sqrt(jnp.sum(kk * kk, axis=-1, keepdims=True)), 1e-12)
    kf = (kf * (1.0 + (a - 1.0) * p["k_a"].astype(jnp.float32))).reshape(hs)
    a_h = a.reshape(hs)
    y, s_fin = _wkv_scan(wkv_state.astype(jnp.float32), rf, decay.reshape(hs), kf, vf, -kk, kk * a_h)

    mu = jnp.mean(y, axis=-1, keepdims=True)
    var = jnp.mean(jnp.square(y - mu), axis=-1, keepdims=True)
    yn = ((y - mu) * lax.rsqrt(var + LN_X_EPS)).reshape(bsz, t_len, D_RWKV)
    yn = yn * p["ln_x_w"].astype(jnp.float32) + p["ln_x_b"].astype(jnp.float32)
    bonus = jnp.sum(rf * kf * p["r_k"].astype(jnp.float32), axis=-1, keepdims=True) * vf
    y_r = (yn + bonus.reshape(bsz, t_len, D_RWKV)).astype(h.dtype)
    branch_b = jnp.einsum('btc,cd->btd', y_r * g, p["w_rwkv_out"])

    gates = jax.nn.sigmoid(proj[..., OFF_GATE:OFF_GATE + 2 * D_MODEL])
    merged = gates[..., :D_MODEL] * branch_a + gates[..., D_MODEL:] * branch_b
    out = jnp.einsum('btd,de->bte', merged, p["w_o"])
    return out, new_conv, new_shift, s_fin


def _layer(x, conv_state, shift_state, wkv_state, p):
    m, new_conv, new_shift, new_wkv = _mixer(_rms_norm(x, p["norm_mix_pre"]), conv_state, shift_state, wkv_state, p)
    x = x + _rms_norm(m, p["norm_mix_post"])
    h = _rms_norm(x, p["norm_ffn_pre"])
    up = jnp.einsum('btd,df->btf', h, p["w_ffn_up"])
    f = jnp.einsum('btf,fd->btd', jax.nn.silu(up[..., :D_FF]) * up[..., D_FF:], p["w_ffn_down"])
    x = x + _rms_norm(f, p["norm_ffn_post"])
    return x, new_conv.astype(x.dtype), new_shift.astype(x.dtype), new_wkv.astype(x.dtype)


def setup_inputs(seed: int = 0) -> dict:
    key = jax.random.key(seed)
    ks = jax.random.split(key, 32)
    nrm = lambda i, shape, s: jax.random.normal(ks[i], shape, jnp.float32) * s
    L = DEPTH
    return {
        "x_prompt": nrm(0, (BATCH, SEQ, D_MODEL), 1.0),
        "x_sample": nrm(1, (DEC_BATCH, DEC_SEQ, D_MODEL), 1.0),
        "state_conv": nrm(2, (L, DEC_BATCH, CONV_W - 1, D_CONV), 1.0),
        "state_shift": nrm(3, (L, DEC_BATCH, RWKV_COLS), 1.0),
        "state_wkv": nrm(4, (L, DEC_BATCH, N_HEADS, HEAD_SIZE, HEAD_SIZE), 0.3),
        "norm_mix_pre": 1.0 + nrm(5, (L, D_MODEL), 0.05),
        "norm_mix_post": 1.0 + nrm(6, (L, D_MODEL), 0.05),
        "w_in": nrm(7, (L, D_MODEL, IN_COLS), D_MODEL ** -0.5),
        "mu_shift": jax.random.uniform(ks[8], (L, RWKV_COLS), jnp.float32, 0.1, 0.9),
        "conv_w": nrm(9, (L, CONV_W, D_CONV), CONV_W ** -0.5),
        "w_decay0": nrm(10, (L, D_RWKV), 0.5) - 0.5,
        "w_decay2": nrm(11, (L, D_DECAY_LORA, D_RWKV), 0.1),
        "a0": nrm(12, (L, D_RWKV), 0.1),
        "a2": nrm(13, (L, D_AAA_LORA, D_RWKV), 0.5 * D_AAA_LORA ** -0.5),
        "g2": nrm(14, (L, D_GATE_LORA, D_RWKV), D_GATE_LORA ** -0.5),
        "k_k": 0.85 + nrm(15, (L, D_RWKV), 0.05),
        "k_a": 1.0 + nrm(16, (L, D_RWKV), 0.05),
        "r_k": nrm(17, (L, N_HEADS, HEAD_SIZE), 0.1),
        "ln_x_w": 1.0 + nrm(18, (L, D_RWKV), 0.05),
        "ln_x_b": nrm(19, (L, D_RWKV), 0.01),
        "w_conv_out": nrm(20, (L, D_CONV, D_MODEL), D_CONV ** -0.5),
        "w_rwkv_out": nrm(21, (L, D_RWKV, D_MODEL), D_RWKV ** -0.5),
        "w_o": nrm(22, (L, D_MODEL, D_MODEL), D_MODEL ** -0.5),
        "norm_ffn_pre": 1.0 + nrm(23, (L, D_MODEL), 0.05),
        "norm_ffn_post": 1.0 + nrm(24, (L, D_MODEL), 0.05),
        "w_ffn_up": nrm(25, (L, D_MODEL, 2 * D_FF), D_MODEL ** -0.5),
        "w_ffn_down": nrm(26, (L, D_FF, D_MODEL), D_FF ** -0.5),
    }


def reference(x_prompt, x_sample, state_conv, state_shift, state_wkv,
              norm_mix_pre, norm_mix_post, w_in, mu_shift, conv_w,
              w_decay0, w_decay2, a0, a2, g2, k_k, k_a, r_k, ln_x_w, ln_x_b,
              w_conv_out, w_rwkv_out, w_o, norm_ffn_pre, norm_ffn_post,
              w_ffn_up, w_ffn_down):
    dt = x_prompt.dtype
    xp, xs = x_prompt, x_sample
    conv_p, shift_p, wkv_p, conv_s, shift_s, wkv_s = [], [], [], [], [], []
    for l in range(DEPTH):
        p = dict(norm_mix_pre=norm_mix_pre[l], norm_mix_post=norm_mix_post[l], w_in=w_in[l],
                 mu_shift=mu_shift[l], conv_w=conv_w[l], w_decay0=w_decay0[l], w_decay2=w_decay2[l],
                 a0=a0[l], a2=a2[l], g2=g2[l], k_k=k_k[l], k_a=k_a[l], r_k=r_k[l],
                 ln_x_w=ln_x_w[l], ln_x_b=ln_x_b[l], w_conv_out=w_conv_out[l],
                 w_rwkv_out=w_rwkv_out[l], w_o=w_o[l], norm_ffn_pre=norm_ffn_pre[l],
                 norm_ffn_post=norm_ffn_post[l], w_ffn_up=w_ffn_up[l], w_ffn_down=w_ffn_down[l])
        xp, c1, s1, k1 = _layer(xp,
                                jnp.zeros((BATCH, CONV_W - 1, D_CONV), dt),
                                jnp.zeros((BATCH, RWKV_COLS), dt),
                                jnp.zeros((BATCH, N_HEADS, HEAD_SIZE, HEAD_SIZE), dt), p)
        xs, c2, s2, k2 = _layer(xs, state_conv[l], state_shift[l], state_wkv[l], p)
        conv_p.append(c1); shift_p.append(s1); wkv_p.append(k1)
        conv_s.append(c2); shift_s.append(s2); wkv_s.append(k2)
    return (xp, xs,
            jnp.stack(conv_p, 0), jnp.stack(shift_p, 0), jnp.stack(wkv_p, 0),
            jnp.stack(conv_s, 0), jnp.stack(shift_s, 0), jnp.stack(wkv_s, 0))
```

```cpp
#include <hip/hip_runtime.h>
#include <cstdio>
#include <cstdint>

#ifndef MK_PER_PHASE
#define MK_PER_PHASE 0
#endif

namespace pg8 {
#define PG8_LAS __attribute__((address_space(3)))
typedef unsigned short bf16_t;
typedef short bf16x8 __attribute__((ext_vector_type(8)));
typedef float f32x4 __attribute__((ext_vector_type(4)));
typedef float f32x2 __attribute__((ext_vector_type(2)));
typedef unsigned u32x4 __attribute__((ext_vector_type(4)));
constexpr int BM = 256, BK = 64, HALF = 128, HTB = HALF * BK * 2, STAGE_BYTES = 8 * HTB, NXCD = 8, WGM = 8;

__host__ __device__ __forceinline__ int lds_byte(int r, int c) { const int st = (r >> 4) * 2 + (c >> 5), rr = r & 15, cc = c & 31, ob = rr * 64 + cc * 2; return st * 1024 + (ob ^ (((ob >> 9) & 1) << 5)); }
__host__ __device__ __forceinline__ void stage_rc(int b, int& R, int& C) { const int st = b / 1024, sb = b % 1024, swz = sb ^ (((sb >> 9) & 1) << 5); R = (st >> 1) * 16 + swz / 64; C = (st & 1) * 32 + (swz % 64) / 2; }
__host__ __device__ __forceinline__ int perm32(int rho) { const int n = rho >> 4, i = rho & 15; return 8 * (i >> 2) + 4 * n + (i & 3); }

struct Unit { int pm, pn; };
struct Gemm { const bf16_t* A0; const bf16_t* A1; int split_pn; const bf16_t* Bt; int lda, ldb, K; };

struct StaticOrder {
    int nM, nN, nwg, G, c;
    __host__ __device__ void init(int M, int N, int G_, int c_) { nM = M / BM; nN = N / BM; nwg = nM * nN; G = G_; c = c_; }
    __host__ __device__ bool next(int i, Unit& u) const {
        const long L = (long)i * G + c; if (L >= nwg) return false;
        int wgid = (int)L; { const int q = nwg / NXCD, r = nwg % NXCD, xcd = wgid % NXCD, off = wgid / NXCD; wgid = (xcd < r ? xcd * (q + 1) : r * (q + 1) + (xcd - r) * q) + off; }
        const int nig = WGM * nN, gid = wgid / nig, fm = gid * WGM, gsz = (nM - fm) < WGM ? (nM - fm) : WGM;
        u.pm = fm + ((wgid % nig) % gsz); u.pn = (wgid % nig) / gsz; return true;
    }
};

__device__ __forceinline__ unsigned cvt_pk_bf16(float lo, float hi) { unsigned r; asm volatile("v_cvt_pk_bf16_f32 %0, %1, %2" : "=v"(r) : "v"(lo), "v"(hi)); return r; }
__device__ __forceinline__ float bf_lo(unsigned w) { return __uint_as_float(w << 16); }
__device__ __forceinline__ float bf_hi(unsigned w) { return __uint_as_float(w & 0xffff0000u); }
__device__ __forceinline__ float sigmoidf_(float x) { return 1.0f / (1.0f + __expf(-x)); }

struct EpiF32 {
    static constexpr bool PERM = false;
    float* C; int ldc;
    __device__ __forceinline__ void operator()(const f32x4 (&acc)[2][2][4][2], const Unit& u, int wr, int wc, int fr, int fq) const {
        const int row0 = u.pm * BM + wr * 64 + fr, col0 = u.pn * BM + wc * 32 + 4 * fq;
#pragma unroll
        for (int ai = 0; ai < 2; ++ai)
#pragma unroll
            for (int m = 0; m < 4; ++m) { float* rowp = C + (size_t)(row0 + ai * HALF + m * 16) * ldc + col0;
#pragma unroll
                for (int bj = 0; bj < 2; ++bj)
#pragma unroll
                    for (int n = 0; n < 2; ++n) *(f32x4*)(rowp + bj * HALF + n * 16) = acc[ai][bj][m][n]; }
    }
};
template <int MODE> struct EpiBf {
    static constexpr bool PERM = true;
    bf16_t* O0; int ld0; bf16_t* O1; int ld1; int split;
    __device__ __forceinline__ void operator()(const f32x4 (&acc)[2][2][4][2], const Unit& u, int wr, int wc, int fr, int fq) const {
        const int row0 = u.pm * BM + wr * 64 + fr; int colt = u.pn * BM; bf16_t* base = O0; int ldc = ld0;
        if (MODE == 0 && colt >= split) { base = O1; ldc = ld1; colt -= split; }
        const int col0 = colt + wc * 32 + 8 * fq;
#pragma unroll
        for (int ai = 0; ai < 2; ++ai)
#pragma unroll
            for (int m = 0; m < 4; ++m) { bf16_t* rowp = base + (size_t)(row0 + ai * HALF + m * 16) * ldc + col0;
#pragma unroll
                for (int bj = 0; bj < 2; ++bj) { f32x4 v0 = acc[ai][bj][m][0], v1 = acc[ai][bj][m][1];
                    if (MODE == 1) {
#pragma unroll
                        for (int e = 0; e < 4; ++e) { v0[e] = sigmoidf_(v0[e]); v1[e] = sigmoidf_(v1[e]); } }
                    if (MODE == 2) { const u32x4 gw = *(const u32x4*)(rowp + bj * HALF);
                        v0[0] *= bf_lo(gw.x); v0[1] *= bf_hi(gw.x); v0[2] *= bf_lo(gw.y); v0[3] *= bf_hi(gw.y);
                        v1[0] *= bf_lo(gw.z); v1[1] *= bf_hi(gw.z); v1[2] *= bf_lo(gw.w); v1[3] *= bf_hi(gw.w); }
                    u32x4 w; w.x = cvt_pk_bf16(v0[0], v0[1]); w.y = cvt_pk_bf16(v0[2], v0[3]); w.z = cvt_pk_bf16(v1[0], v1[1]); w.w = cvt_pk_bf16(v1[2], v1[3]);
                    *(u32x4*)(rowp + bj * HALF) = w; } }
    }
};
struct EpiSwiglu {
    static constexpr bool PERM = true;
    bf16_t* H; int ldc;
    __device__ __forceinline__ void operator()(const f32x4 (&acc)[2][2][4][2], const Unit& u, int wr, int wc, int fr, int fq) const {
        const int row0 = u.pm * BM + wr * 64 + fr, col0 = u.pn * HALF + wc * 32 + 8 * fq;
#pragma unroll
        for (int ai = 0; ai < 2; ++ai)
#pragma unroll
            for (int m = 0; m < 4; ++m) { bf16_t* rowp = H + (size_t)(row0 + ai * HALF + m * 16) * ldc + col0;
                f32x4 v0 = acc[ai][0][m][0], v1 = acc[ai][0][m][1]; const f32x4 g0 = acc[ai][1][m][0], g1 = acc[ai][1][m][1];
#pragma unroll
                for (int e = 0; e < 4; ++e) { v0[e] = v0[e] * sigmoidf_(v0[e]) * g0[e]; v1[e] = v1[e] * sigmoidf_(v1[e]) * g1[e]; }
                u32x4 w; w.x = cvt_pk_bf16(v0[0], v0[1]); w.y = cvt_pk_bf16(v0[2], v0[3]); w.z = cvt_pk_bf16(v1[0], v1[1]); w.w = cvt_pk_bf16(v1[2], v1[3]);
                *(u32x4*)rowp = w; }
    }
};

template <class Epi, class Sched, bool ALIGN_EPI>
__device__ __forceinline__ void gemm_phase(PG8_LAS unsigned char* lds, const Gemm g, const Sched& S, const Epi& E, const int tid) {
    const int wid = __builtin_amdgcn_readfirstlane(tid >> 6), lane = tid & 63, wr = wid >> 2, wc = wid & 3, fr = lane & 15, fq = lane >> 4;
    const int K = g.K, nt = K / BK;
    unsigned voffA[2], voffB[2];
#pragma unroll
    for (int i = 0; i < 2; ++i) { int R, C; stage_rc(tid * 16 + i * 8192, R, C); const int Rb = Epi::PERM ? ((R & ~31) + perm32(R & 31)) : R;
        voffA[i] = (unsigned)(R * g.lda + C) * 2u; voffB[i] = (unsigned)(Rb * g.ldb + C) * 2u; }
    const size_t kstep = (size_t)(BK * 2);
    const size_t hstepA = (size_t)HALF * g.lda * 2, hstepB = (size_t)HALF * g.ldb * 2;
    const size_t tstepA = 2 * hstepA, tstepB = 2 * hstepB;
    const unsigned ldsw = (unsigned)wid * 1024u;
    const int aoff = lds_byte(wr * 64 + fr, fq * 8), boff = lds_byte(wc * 32 + fr, fq * 8);
#define PG8_SA(b, h) (((b) * 2 + (h)) * HTB)
#define PG8_SB(b, h) ((4 + (b) * 2 + (h)) * HTB)
#define PG8_STAGE(bufoff, gbase, voff) do { _Pragma("unroll") for (int _i = 0; _i < 2; ++_i) \
        __builtin_amdgcn_global_load_lds((const unsigned*)((const char*)(gbase) + (voff)[_i]), (PG8_LAS unsigned*)(lds + (bufoff) + ldsw + _i * 8192), 16, 0, 0); } while (0)
#define PG8_LDA(dst, b, h) do { _Pragma("unroll") for (int m = 0; m < 4; ++m) _Pragma("unroll") for (int k = 0; k < 2; ++k) dst[m][k] = *(const PG8_LAS bf16x8*)(lds + PG8_SA(b, h) + aoff + m * 2048 + k * 1024); } while (0)
#define PG8_LDB(dst, b, h) do { _Pragma("unroll") for (int n = 0; n < 2; ++n) _Pragma("unroll") for (int k = 0; k < 2; ++k) dst[n][k] = *(const PG8_LAS bf16x8*)(lds + PG8_SB(b, h) + boff + n * 2048 + k * 1024); } while (0)
#define PG8_MMA(ai, bj, At, Bt) do { __builtin_amdgcn_s_setprio(1); _Pragma("unroll") for (int m = 0; m < 4; ++m) _Pragma("unroll") for (int n = 0; n < 2; ++n) _Pragma("unroll") for (int k = 0; k < 2; ++k) \
        acc[ai][bj][m][n] = __builtin_amdgcn_mfma_f32_16x16x32_bf16(Bt[n][k], At[m][k], acc[ai][bj][m][n], 0, 0, 0); __builtin_amdgcn_s_setprio(0); } while (0)
#define PG8_WAIT_V(n) asm volatile("s_waitcnt vmcnt(" #n ")" ::: "memory")
#define PG8_WAIT_L(n) asm volatile("s_waitcnt lgkmcnt(" #n ")" ::: "memory")
#define PG8_BAR __builtin_amdgcn_s_barrier()
#define PG8_SCHED __builtin_amdgcn_sched_barrier(0)
#define PG8_APTR(u) ((const char*)((u).pn < g.split_pn ? g.A0 : g.A1) + (size_t)(u).pm * tstepA)
#define PG8_BPTR(u) ((const char*)g.Bt + (size_t)(u).pn * tstepB)
    Unit cur, nxt; int ui = 0;
    if (!S.next(0, cur)) return;
    f32x4 acc[2][2][4][2];
#pragma unroll
    for (int a = 0; a < 2; ++a)
#pragma unroll
        for (int b = 0; b < 2; ++b)
#pragma unroll
            for (int m = 0; m < 4; ++m)
#pragma unroll
                for (int n = 0; n < 2; ++n) acc[a][b][m][n] = (f32x4){0.f, 0.f, 0.f, 0.f};
    bf16x8 At[4][2], B0[2][2], B1[2][2];
    const char* cA = PG8_APTR(cur); const char* cB = PG8_BPTR(cur);
    PG8_STAGE(PG8_SB(0, 0), cB, voffB); PG8_STAGE(PG8_SB(0, 1), cB + hstepB, voffB); PG8_STAGE(PG8_SA(0, 0), cA, voffA); PG8_STAGE(PG8_SA(0, 1), cA + hstepA, voffA);
    if (wr == 1) PG8_BAR;
    PG8_WAIT_V(2); PG8_BAR;
    PG8_STAGE(PG8_SB(1, 0), cB + kstep, voffB); PG8_STAGE(PG8_SA(1, 0), cA + kstep, voffA); PG8_STAGE(PG8_SB(1, 1), cB + hstepB + kstep, voffB);
    PG8_WAIT_V(6); PG8_BAR;
    for (;;) {
        const bool has_next = S.next(ui + 1, nxt);
        const char* nA = has_next ? PG8_APTR(nxt) : cA; const char* nB = has_next ? PG8_BPTR(nxt) : cB;
        for (int t = 0; t < nt; t += 2) {
            const bool last = (t == nt - 2);
            const char* a1 = cA + (size_t)(t + 1) * kstep;
            const char* a2 = last ? nA : cA + (size_t)(t + 2) * kstep; const char* b2 = last ? nB : cB + (size_t)(t + 2) * kstep;
            const char* a3 = a2 + kstep; const char* b3 = b2 + kstep;
            PG8_LDB(B0, 0, 0); PG8_LDB(B1, 0, 1); PG8_SCHED; PG8_LDA(At, 0, 0); PG8_STAGE(PG8_SA(1, 1), a1 + hstepA, voffA);
            PG8_WAIT_V(8); PG8_WAIT_L(0); PG8_BAR; PG8_MMA(0, 0, At, B0); PG8_MMA(0, 1, At, B1); PG8_BAR; PG8_SCHED;
            PG8_LDA(At, 0, 1); PG8_STAGE(PG8_SB(0, 0), b2, voffB); PG8_STAGE(PG8_SB(0, 1), b2 + hstepB, voffB); PG8_STAGE(PG8_SA(0, 0), a2, voffA);
            PG8_WAIT_V(8); PG8_WAIT_L(0); PG8_BAR; PG8_MMA(1, 0, At, B0); PG8_MMA(1, 1, At, B1); PG8_BAR; PG8_SCHED;
            PG8_LDB(B0, 1, 0); PG8_LDB(B1, 1, 1); PG8_SCHED; PG8_LDA(At, 1, 0); PG8_STAGE(PG8_SA(0, 1), a2 + hstepA, voffA);
            PG8_WAIT_V(8); PG8_WAIT_L(0); PG8_BAR; PG8_MMA(0, 0, At, B0); PG8_MMA(0, 1, At, B1); PG8_BAR; PG8_SCHED;
            PG8_LDA(At, 1, 1); PG8_STAGE(PG8_SB(1, 0), b3, voffB); PG8_STAGE(PG8_SB(1, 1), b3 + hstepB, voffB); PG8_STAGE(PG8_SA(1, 0), a3, voffA);
            PG8_WAIT_V(8); PG8_WAIT_L(0); PG8_BAR; PG8_MMA(1, 0, At, B0); PG8_MMA(1, 1, At, B1); PG8_BAR; PG8_SCHED;
        }
        if constexpr (ALIGN_EPI) { if (wr == 0) PG8_BAR; }
        E(acc, cur, wr, wc, fr, fq);
        if (!has_next) break;
#pragma unroll
        for (int a = 0; a < 2; ++a)
#pragma unroll
            for (int b = 0; b < 2; ++b)
#pragma unroll
                for (int m = 0; m < 4; ++m)
#pragma unroll
                    for (int n = 0; n < 2; ++n) acc[a][b][m][n] = (f32x4){0.f, 0.f, 0.f, 0.f};
        cur = nxt; cA = nA; cB = nB; ++ui;
        if constexpr (ALIGN_EPI) { if (wr == 1) PG8_BAR; }
    }
    PG8_WAIT_V(0);
    if constexpr (!ALIGN_EPI) { if (wr == 0) PG8_BAR; }
    PG8_BAR;
#undef PG8_SA
#undef PG8_SB
#undef PG8_STAGE
#undef PG8_LDA
#undef PG8_LDB
#undef PG8_MMA
#undef PG8_WAIT_V
#undef PG8_WAIT_L
#undef PG8_BAR
#undef PG8_SCHED
#undef PG8_APTR
#undef PG8_BPTR
}
}

constexpr int DM = 1024, TP = 16384, NSB = 32, TS = 64, MT = TP + NSB * TS;
constexpr int DEPTH = 2, DC = 512, DR = 512, NH = 8, HS = 64;
constexpr int RWC = 1792, NCR = 3328, NGATE = 2048, INC = 5376, DFF = 2816;
constexpr int CH = 128, NCH = TP / CH;
constexpr float RMS_EPS = 1e-6f, LNX_EPS = 64e-5f;

constexpr size_t MiB = 1u << 20;
constexpr size_t WS_CTL = 0, CTL_ZERO_BYTES = 64 * 1024;
constexpr size_t WS_W = 1 * MiB;
constexpr size_t W_INA = WS_W, W_ING = W_INA + (size_t)NCR * DM * 2, W_CR = W_ING + (size_t)NGATE * DM * 2, W_O2 = W_CR + (size_t)2048 * 512 * 2;
constexpr size_t W_UP = WS_W, W_DN = W_UP + (size_t)2 * DFF * DM * 2;
constexpr size_t WS_SS = 18 * MiB;
constexpr size_t WS_XB = 34 * MiB;
constexpr size_t WS_PC = 70 * MiB;
constexpr size_t WS_WD = 70 * MiB, WS_AL = 106 * MiB;
constexpr size_t WS_PR = 124 * MiB;
constexpr size_t WS_CA = 187 * MiB;
constexpr size_t WS_GO = 205 * MiB;
constexpr size_t WS_PQ = 223 * MiB;
constexpr size_t WS_YB = 223 * MiB;
constexpr size_t WS_GATES = 70 * MiB;
constexpr size_t WS_MOUT = 142 * MiB;
constexpr size_t WS_H = 70 * MiB;
constexpr size_t WS_FOUT = 169 * MiB;
constexpr size_t WS_END = 256 * MiB;
static_assert(W_O2 + (size_t)1024 * 2048 * 2 <= WS_SS && W_DN + (size_t)DM * DFF * 2 <= WS_SS, "weights");
static_assert(WS_SS + (size_t)NCH * NH * 16384 <= WS_XB && WS_XB + (size_t)MT * DM * 2 <= WS_PC && WS_PC + (size_t)MT * 1536 * 2 <= WS_PR && WS_PR + (size_t)MT * RWC * 2 <= WS_CA, "map1");
static_assert(WS_CA + (size_t)MT * 512 * 2 <= WS_GO && WS_GO + (size_t)MT * 512 * 2 <= WS_PQ && WS_PQ + (size_t)NCH * NH * 32768 <= WS_END, "map2");
static_assert(WS_WD + (size_t)MT * 512 * 4 <= WS_AL && WS_AL + (size_t)MT * 512 * 2 <= WS_PR, "map3");
static_assert(WS_GATES + (size_t)MT * 2048 * 2 <= WS_MOUT && WS_MOUT + (size_t)MT * DM * 4 <= WS_PQ && WS_H + (size_t)MT * DFF * 2 <= WS_FOUT && WS_FOUT + (size_t)MT * DM * 4 <= WS_END, "map4");
constexpr int CW_BAR = 4096;

constexpr size_t O_Y = 0, O_CONVP = (size_t)MT * DM, O_SHIFTP = O_CONVP + 2 * 2 * 512, O_WKVP = O_SHIFTP + 2 * RWC, O_CONVS = O_WKVP + 2 * 8 * 4096,
                 O_SHIFTS = O_CONVS + (size_t)2 * 32 * 2 * 512, O_WKVS = O_SHIFTS + (size_t)2 * 32 * RWC, O_END = O_WKVS + (size_t)2 * 32 * 8 * 4096;

constexpr int RING_BYTES = 131072, MISC_OFF = RING_BYTES + 320, LDS_BYTES = 147456;

#define GAS __attribute__((address_space(1)))
#define LAS __attribute__((address_space(3)))
typedef unsigned short bf16;
typedef unsigned v4u __attribute__((ext_vector_type(4)));
typedef unsigned v2u __attribute__((ext_vector_type(2)));
typedef float f32x4 __attribute__((ext_vector_type(4)));
typedef float f32x16 __attribute__((ext_vector_type(16)));
typedef short bf16x8 __attribute__((ext_vector_type(8)));
typedef GAS unsigned gu32;
#define LDS_WAIT() asm volatile("s_waitcnt lgkmcnt(0)" ::: "memory")
#define VM_WAIT() asm volatile("s_waitcnt vmcnt(0)" ::: "memory")
__device__ __forceinline__ unsigned f2bf(float f) { unsigned u = __builtin_bit_cast(unsigned, f); return (u + 0x7fffu + ((u >> 16) & 1u)) >> 16; }
__device__ __forceinline__ unsigned pk2(float lo, float hi) { return f2bf(lo) | (f2bf(hi) << 16); }
__device__ __forceinline__ float bf2f(unsigned short b) { return __uint_as_float((unsigned)b << 16); }
__device__ __forceinline__ float sigm(float x) { return 1.0f / (1.0f + __expf(-x)); }

#define XB_TMO      128
#define XB_XCNT(j)  (256  + 64 * (j))
#define XB_XSUB(j)  (1280 + 64 * (j))
#define XB_XGEN(j)  (2304 + 64 * (j))
#define XB_TOP      3328
#define XB_TOPGEN   3392
#define XCD_BAR_WORDS 3456
#define XB_SPIN_CAP (1u << 18)
__device__ __forceinline__ unsigned xb_ld(unsigned* p)              { return __hip_atomic_load(p, __ATOMIC_RELAXED, __HIP_MEMORY_SCOPE_AGENT); }
__device__ __forceinline__ unsigned xb_add(unsigned* p, unsigned v) { return __hip_atomic_fetch_add(p, v, __ATOMIC_RELAXED, __HIP_MEMORY_SCOPE_AGENT); }
__device__ __forceinline__ unsigned xb_xcc_id() { return (unsigned)__builtin_amdgcn_s_getreg((3 << 11) | 20) & 0xFu; }
#define XB_SPIN(cond, bar) do { unsigned _sp = 0; while (cond) { __builtin_amdgcn_s_sleep(1); \
    if ((++_sp & 255u) == 0u) { if (xb_ld(&(bar)[XB_TMO])) break; if (_sp > XB_SPIN_CAP) { atomicAdd(&(bar)[XB_TMO], 1u); break; } } } } while (0)
struct XcdBarrier { unsigned* bar; unsigned x; volatile LAS unsigned* st; };
__device__ __forceinline__ XcdBarrier xcd_barrier_post(unsigned* bar, volatile LAS unsigned* st) {
    XcdBarrier b; b.bar = bar; b.x = xb_xcc_id(); b.st = st;
    if (threadIdx.x == 0) (void)xb_add(&bar[XB_XCNT(b.x)], 1u);
    return b;
}
__device__ __forceinline__ void xcd_barrier_complete(unsigned* bar, unsigned x, unsigned& nloc, unsigned& nx) {
    const unsigned G = gridDim.x * gridDim.y * gridDim.z;
    unsigned sum, cnt, mine, sp = 0u;
    for (;;) {
        sum = 0u; cnt = 0u; mine = 0u;
#pragma unroll
        for (unsigned j = 0; j < 16; ++j) { const unsigned c = xb_ld(&bar[XB_XCNT(j)]); sum += c; cnt += (c > 0u) ? 1u : 0u; mine = (j == x) ? c : mine; }
        if (sum == G) break;
        __builtin_amdgcn_s_sleep(1);
        if ((++sp & 255u) == 0u) { if (xb_ld(&bar[XB_TMO])) break; if (sp > XB_SPIN_CAP) { atomicAdd(&bar[XB_TMO], 1u); break; } }
    }
    nloc = mine > 0u ? mine : 1u; nx = cnt > 0u ? cnt : 1u;
}
__device__ __forceinline__ void xcd_barrier(const XcdBarrier& b) {
    asm volatile("s_waitcnt vmcnt(0)" ::: "memory");
    __syncthreads();
    if (threadIdx.x == 0) {
        unsigned* bar = b.bar;
        __builtin_amdgcn_s_waitcnt(0);
        unsigned nloc = b.st[0], nx = b.st[1];
        if (nloc == 0u) { xcd_barrier_complete(bar, b.x, nloc, nx); b.st[0] = nloc; b.st[1] = nx; }
        const unsigned old = xb_add(&bar[XB_XSUB(b.x)], 1u);
        const unsigned gen = old / nloc;
        if (old + 1u == (gen + 1u) * nloc) {
            __builtin_amdgcn_fence(__ATOMIC_RELEASE, "agent");
            asm volatile("s_waitcnt vmcnt(0)" ::: "memory");
            const unsigned og = xb_add(&bar[XB_TOP], 1u);
            const unsigned tg = og / nx;
            if (og + 1u == (tg + 1u) * nx) xb_add(&bar[XB_TOPGEN], 1u);
            else XB_SPIN(xb_ld(&bar[XB_TOPGEN]) == tg, bar);
            __builtin_amdgcn_fence(__ATOMIC_ACQUIRE, "agent");
            xb_add(&bar[XB_XGEN(b.x)], 1u);
            asm volatile("s_waitcnt vmcnt(0)" ::: "memory");
        } else {
            XB_SPIN(xb_ld(&bar[XB_XGEN(b.x)]) == gen, bar);
            __builtin_amdgcn_fence(__ATOMIC_ACQUIRE, "agent");
            asm volatile("s_waitcnt vmcnt(0)" ::: "memory");
        }
    }
    __syncthreads();
}

__device__ __forceinline__ float wave_sum(float v) {
#pragma unroll
    for (int o = 1; o < 64; o <<= 1) v += __shfl_xor(v, o);
    return v;
}
__device__ __forceinline__ float dpp_xor1(float x) { return __builtin_bit_cast(float, __builtin_amdgcn_update_dpp(0, __builtin_bit_cast(int, x), 0xB1, 0xF, 0xF, true)); }
__device__ __forceinline__ float dpp_xor2(float x) { return __builtin_bit_cast(float, __builtin_amdgcn_update_dpp(0, __builtin_bit_cast(int, x), 0x4E, 0xF, 0xF, true)); }
__device__ __forceinline__ float quad_sum(float x) { x += dpp_xor1(x); x += dpp_xor2(x); return x; }

__device__ __forceinline__ int opq(int i) { asm volatile("" : "+s"(i)); return i; }
struct Args {
    const float* in[27]; float* out; unsigned char* ws; int ph_lo, ph_hi; int pad0, pad1;
};

__device__ __forceinline__ void transpose_item(const float* W, int ldw, int k0, int n0, bf16* WT, int ldk, int drow0, int kdst0, LAS float* scr, int lane) {
#pragma unroll 8
    for (int i = 0; i < 32; ++i) { const int kk = 2 * i + (lane >> 5); scr[kk * 33 + (lane & 31)] = W[(size_t)(k0 + kk) * ldw + n0 + (lane & 31)]; }
    LDS_WAIT(); asm volatile("" ::: "memory");
    const int c = lane & 7;
#pragma unroll
    for (int j = 0; j < 4; ++j) { const int n = (lane >> 3) + 8 * j; const LAS float* s = scr + (8 * c) * 33 + n;
        v4u o; o.x = pk2(s[0 * 33], s[1 * 33]); o.y = pk2(s[2 * 33], s[3 * 33]); o.z = pk2(s[4 * 33], s[5 * 33]); o.w = pk2(s[6 * 33], s[7 * 33]);
        *(GAS v4u*)(WT + (size_t)(drow0 + n0 + n) * ldk + kdst0 + k0 + 8 * c) = o; }
    LDS_WAIT(); asm volatile("" ::: "memory");
}

__device__ __forceinline__ void rms_row_to_bf16(const float* xrow, const float* g, bf16* orow, int lane) {
    const GAS f32x4* xr = (const GAS f32x4*)xrow + lane; const GAS f32x4* gr = (const GAS f32x4*)g + lane;
    f32x4 v[4]; float s = 0.f;
#pragma unroll
    for (int j = 0; j < 4; ++j) { v[j] = xr[64 * j]; s += (v[j].x * v[j].x + v[j].y * v[j].y) + (v[j].z * v[j].z + v[j].w * v[j].w); }
    const float rs = 1.0f / sqrtf(wave_sum(s) * (1.f / DM) + RMS_EPS);
    GAS v2u* o8 = (GAS v2u*)orow + lane;
#pragma unroll
    for (int j = 0; j < 4; ++j) { const f32x4 gg = gr[64 * j]; v2u o; o.x = pk2(v[j].x * rs * gg.x, v[j].y * rs * gg.y); o.y = pk2(v[j].z * rs * gg.z, v[j].w * rs * gg.w); o8[64 * j] = o; }
}
__device__ __forceinline__ void resid_norm_row(const float* frow, const float* xin, const float* g1, float* xout, const float* g2, bf16* orow, int lane) {
    const GAS f32x4* fr = (const GAS f32x4*)frow + lane; const GAS f32x4* xr = (const GAS f32x4*)xin + lane; const GAS f32x4* g1r = (const GAS f32x4*)g1 + lane;
    f32x4 f[4], x[4]; float s = 0.f;
#pragma unroll
    for (int j = 0; j < 4; ++j) { f[j] = fr[64 * j]; x[j] = xr[64 * j]; s += (f[j].x * f[j].x + f[j].y * f[j].y) + (f[j].z * f[j].z + f[j].w * f[j].w); }
    const float rs = 1.0f / sqrtf(wave_sum(s) * (1.f / DM) + RMS_EPS);
    float s2 = 0.f;
    GAS f32x4* xo = (GAS f32x4*)xout + lane;
#pragma unroll
    for (int j = 0; j < 4; ++j) { const f32x4 gg = g1r[64 * j]; x[j] = x[j] + f[j] * rs * gg; xo[64 * j] = x[j]; s2 += (x[j].x * x[j].x + x[j].y * x[j].y) + (x[j].z * x[j].z + x[j].w * x[j].w); }
    if (g2) {
        const float rs2 = 1.0f / sqrtf(wave_sum(s2) * (1.f / DM) + RMS_EPS);
        const GAS f32x4* g2r = (const GAS f32x4*)g2 + lane; GAS v2u* o8 = (GAS v2u*)orow + lane;
#pragma unroll
        for (int j = 0; j < 4; ++j) { const f32x4 gg = g2r[64 * j]; v2u o; o.x = pk2(x[j].x * rs2 * gg.x, x[j].y * rs2 * gg.y); o.y = pk2(x[j].z * rs2 * gg.z, x[j].w * rs2 * gg.w); o8[64 * j] = o; }
    }
}

__device__ __forceinline__ void row_info(int m, int& pos, int& len, int& sb) { if (m < TP) { pos = m; len = TP; sb = -1; } else { const int r = m - TP; sb = r >> 6; pos = r & 63; len = TS; } }

struct ScanCtx {
    const bf16* PR; const float* WD; const _Float16* AL; const _Float16* GO; bf16* YB;
    const float* mu; const float* k_k; const float* k_a; const float* r_k; const float* lnw; const float* lnb;
};
template <int KIND>
__device__ __forceinline__ void scan_task(const ScanCtx& C, LAS float* st, int lane_, int h, int m0, int ntok, const float* prev_state  , bool has_prev_row,
                                          const float* S0  , const float* S0T  , float* out0  ) {
    int lane = lane_; asm volatile("" : "+v"(lane));
    const int p = lane >> 2, q = lane & 3, col = 64 * h + lane;
    f32x4 s[4][4];
#pragma unroll
    for (int r = 0; r < 4; ++r)
#pragma unroll
        for (int i = 0; i < 4; ++i) s[r][i] = (f32x4){0.f, 0.f, 0.f, 0.f};
    if (KIND == 0) {
#pragma unroll
        for (int r = 0; r < 4; ++r)
#pragma unroll
            for (int i = 0; i < 4; ++i)
#pragma unroll
                for (int e = 0; e < 4; ++e) s[r][i][e] = (4 * p + r == 16 * q + 4 * i + e) ? 1.f : 0.f;
    }
    if (KIND == 2) {
        if (S0) {
#pragma unroll
            for (int r = 0; r < 4; ++r)
#pragma unroll
                for (int i = 0; i < 4; ++i) s[r][i] = *(const GAS f32x4*)(S0 + (4 * p + r) * 64 + 16 * q + 4 * i);
        } else if (S0T) {
#pragma unroll
            for (int i = 0; i < 4; ++i)
#pragma unroll
                for (int e = 0; e < 4; ++e) { const f32x4 t = *(const GAS f32x4*)(S0T + (16 * q + 4 * i + e) * 64 + 4 * p);
                    s[0][i][e] = t.x; s[1][i][e] = t.y; s[2][i][e] = t.z; s[3][i][e] = t.w; }
        }
    }
    const float mu_r = C.mu[col], mu_k = C.mu[512 + col], mu_v = C.mu[1024 + col], kkc = C.k_k[col], kac = C.k_a[col];
    float rkc = 0.f;
    float lw[4], lb[4];
    if (KIND == 2) {
        rkc = C.r_k[col];
#pragma unroll
        for (int r = 0; r < 4; ++r) { lw[r] = C.lnw[64 * h + 4 * p + r]; lb[r] = C.lnb[64 * h + 4 * p + r]; }
    }
    float prv_r, prv_k, prv_v;
    if (has_prev_row) { const bf16* pp = C.PR + (size_t)(m0 - 1) * RWC; prv_r = bf2f(pp[col]); prv_k = bf2f(pp[512 + col]); prv_v = bf2f(pp[1024 + col]); }
    else if (prev_state) { prv_r = prev_state[col]; prv_k = prev_state[512 + col]; prv_v = prev_state[1024 + col]; }
    else { prv_r = 0.f; prv_k = 0.f; prv_v = 0.f; }

    for (int t0 = 0; t0 < ntok; t0 += 8) {
#pragma unroll
        for (int tb = 0; tb < 8; ++tb) {
            const int m = m0 + t0 + tb; const bf16* pp = C.PR + (size_t)m * RWC;
            const float cr = bf2f(pp[col]), ck = bf2f(pp[512 + col]), cv = bf2f(pp[1024 + col]);
            const float al = (float)C.AL[(size_t)m * 512 + col], w = C.WD[(size_t)m * 512 + col];
            const float r_ = cr + (prv_r - cr) * mu_r, k_ = ck + (prv_k - ck) * mu_k, v_ = cv + (prv_v - cv) * mu_v;
            prv_r = cr; prv_k = ck; prv_v = cv;
            const float kkr = k_ * kkc; const float n2 = wave_sum(kkr * kkr);
            const float kk = kkr / fmaxf(sqrtf(n2), 1e-12f);
            const float kf = k_ * (1.0f + (al - 1.0f) * kac);
            LAS float* o = st + tb * 384;
            o[lane] = w; o[64 + lane] = -kk; o[128 + lane] = kk * al; o[192 + lane] = kf; o[256 + lane] = v_; o[320 + lane] = r_;
            if (KIND == 2) { const float bsum = wave_sum(r_ * kf * rkc); if (lane == 0) st[3072 + tb] = bsum; }
        }
        LDS_WAIT(); __builtin_amdgcn_wave_barrier(); asm volatile("" ::: "memory");
#pragma unroll 2
        for (int tb = 0; tb < 8; ++tb) {
            const LAS float* o = st + tb * 384;
            f32x4 w4[4], a4[4], b4[4], k4[4], r4[4];
#pragma unroll
            for (int i = 0; i < 4; ++i) { w4[i] = *(const LAS f32x4*)(o + 16 * q + 4 * i); a4[i] = *(const LAS f32x4*)(o + 64 + 16 * q + 4 * i); b4[i] = *(const LAS f32x4*)(o + 128 + 16 * q + 4 * i); }
            if (KIND != 0) {
#pragma unroll
                for (int i = 0; i < 4; ++i) k4[i] = *(const LAS f32x4*)(o + 192 + 16 * q + 4 * i); }
            if (KIND == 2) {
#pragma unroll
                for (int i = 0; i < 4; ++i) r4[i] = *(const LAS f32x4*)(o + 320 + 16 * q + 4 * i); }
            f32x4 vv = (f32x4){0.f, 0.f, 0.f, 0.f};
            if (KIND != 0) vv = *(const LAS f32x4*)(o + 256 + 4 * p);
            float sa[4];
#pragma unroll
            for (int r = 0; r < 4; ++r) { f32x4 t = s[r][0] * a4[0]; t += s[r][1] * a4[1]; t += s[r][2] * a4[2]; t += s[r][3] * a4[3]; sa[r] = quad_sum((t.x + t.y) + (t.z + t.w)); }
#pragma unroll
            for (int r = 0; r < 4; ++r)
#pragma unroll
                for (int i = 0; i < 4; ++i) { f32x4 t = s[r][i] * w4[i] + b4[i] * sa[r]; if (KIND != 0) t += k4[i] * vv[r]; s[r][i] = t; }
            if (KIND == 2) {
                float y[4];
#pragma unroll
                for (int r = 0; r < 4; ++r) { f32x4 t = s[r][0] * r4[0]; t += s[r][1] * r4[1]; t += s[r][2] * r4[2]; t += s[r][3] * r4[3]; y[r] = quad_sum((t.x + t.y) + (t.z + t.w)); }
                const float bs = st[3072 + tb];
                float s1 = (y[0] + y[1]) + (y[2] + y[3]), s2 = (y[0] * y[0] + y[1] * y[1]) + (y[2] * y[2] + y[3] * y[3]);
#pragma unroll
                for (int o2 = 4; o2 < 64; o2 <<= 1) { s1 += __shfl_xor(s1, o2); s2 += __shfl_xor(s2, o2); }
                const float mean = s1 * (1.f / 64.f), var = fmaxf(s2 * (1.f / 64.f) - mean * mean, 0.f), rstd = 1.0f / sqrtf(var + LNX_EPS);
                const int m = m0 + t0 + tb;
                if (q == 0) {
                    const _Float16* gp = C.GO + (size_t)m * 512 + 64 * h + 4 * p;
                    float o4[4];
#pragma unroll
                    for (int r = 0; r < 4; ++r) o4[r] = (((y[r] - mean) * rstd) * lw[r] + lb[r] + bs * vv[r]) * (float)gp[r];
                    v2u ow; ow.x = pk2(o4[0], o4[1]); ow.y = pk2(o4[2], o4[3]);
                    *(GAS v2u*)(C.YB + (size_t)m * 512 + 64 * h + 4 * p) = ow;
                }
            }
        }
        __builtin_amdgcn_wave_barrier(); asm volatile("" ::: "memory");
    }
    if (out0) {
        if (KIND == 1) {
#pragma unroll
            for (int i = 0; i < 4; ++i)
#pragma unroll
                for (int e = 0; e < 4; ++e) *(GAS f32x4*)(out0 + (16 * q + 4 * i + e) * 64 + 4 * p) = (f32x4){s[0][i][e], s[1][i][e], s[2][i][e], s[3][i][e]};
        } else {
#pragma unroll
            for (int r = 0; r < 4; ++r)
#pragma unroll
                for (int i = 0; i < 4; ++i) *(GAS f32x4*)(out0 + (4 * p + r) * 64 + 16 * q + 4 * i) = s[r][i];
        }
    }
}

constexpr int PH_PER_LAYER = 14, N_PHASES = DEPTH * PH_PER_LAYER;

__global__ void __launch_bounds__(512, 2) mega(Args args) {
    extern __shared__ __attribute__((aligned(16))) unsigned char lds_raw[];
    LAS unsigned char* lds = (LAS unsigned char*)lds_raw;
    volatile LAS unsigned* MISC = (volatile LAS unsigned*)(lds + MISC_OFF);
    const int G = gridDim.x, bx = blockIdx.x, NGW = G * 8;
    for (int u = threadIdx.x; u < (LDS_BYTES - RING_BYTES) / 4; u += 512) ((LAS unsigned*)(lds + RING_BYTES))[u] = 0u;
    __syncthreads();
    XcdBarrier bar; bar.bar = (unsigned*)(args.ws + WS_CTL) + CW_BAR; bar.x = 0; bar.st = nullptr;
    if (!MK_PER_PHASE) bar = xcd_barrier_post((unsigned*)(args.ws + WS_CTL) + CW_BAR, MISC + 8);
    const int lo = args.ph_lo, hi = args.ph_hi;

#define INP(i) (args.in[opq(i)])
#define WSP(T, off) ((T*)(ws + (off)))
    for (int ph = lo; ph < hi; ++ph) {
        const int l = ph / PH_PER_LAYER, k = ph % PH_PER_LAYER;
        int tid = threadIdx.x; asm volatile("" : "+v"(tid));
        const int lane = tid & 63, wave = __builtin_amdgcn_readfirstlane(tid >> 6), gw = bx * 8 + wave;
        size_t zoff = 0; asm volatile("" : "+s"(zoff));
        unsigned char* ws = args.ws + zoff; float* out = args.out + zoff;
        switch (k) {
        case 0: {
            const float* w_in = INP(7) + (size_t)l * DM * INC; bf16* WinA = WSP(bf16, W_INA); bf16* WinG = WSP(bf16, W_ING); bf16* Wcr = WSP(bf16, W_CR); bf16* Wo2 = WSP(bf16, W_O2); bf16* XB = WSP(bf16, WS_XB);
            LAS float* scr = (LAS float*)(lds + wave * 16384);
            constexpr int I_IN = 16 * (INC / 32), I_C = 8 * 32, I_O = 16 * 32, NIT = I_IN + 2 * I_C + I_O;
            for (int it = gw; it < NIT; it += NGW) {
                int r = it;
                if (r < I_IN) { const int nb = r % (INC / 32), kb = r / (INC / 32); const int n0 = nb * 32;
                    if (n0 < NCR) transpose_item(w_in, INC, kb * 64, n0, WinA, DM, 0, 0, scr, lane); else transpose_item(w_in + NCR, INC, kb * 64, n0 - NCR, WinG, DM, 0, 0, scr, lane);
                    continue; }
                r -= I_IN;
                if (r < I_C) { transpose_item(INP(20) + (size_t)l * DC * DM, DM, (r / 32) * 64, (r % 32) * 32, Wcr, 512, 0, 0, scr, lane); continue; } r -= I_C;
                if (r < I_C) { transpose_item(INP(21) + (size_t)l * DR * DM, DM, (r / 32) * 64, (r % 32) * 32, Wcr, 512, 1024, 0, scr, lane); continue; } r -= I_C;
                { const float* wo = INP(22) + (size_t)l * DM * DM; transpose_item(wo, DM, (r / 32) * 64, (r % 32) * 32, Wo2, 2048, 0, 0, scr, lane); transpose_item(wo, DM, (r / 32) * 64, (r % 32) * 32, Wo2, 2048, 0, 1024, scr, lane); }
            }
            if (l == 0) { const float* g = INP(5);
                const float* x_prompt = INP(0); const float* x_sample = INP(1);
                for (int m = gw; m < MT; m += NGW) { const float* xr = (m < TP) ? x_prompt + (size_t)m * DM : x_sample + (size_t)(m - TP) * DM; rms_row_to_bf16(xr, g, XB + (size_t)m * DM, lane); } }
        } break;
        case 1: {
            bf16* XB = WSP(bf16, WS_XB); bf16* WinA = WSP(bf16, W_INA); bf16* PC = WSP(bf16, WS_PC); bf16* PR = WSP(bf16, WS_PR);
            pg8::Gemm g{XB, XB, 1 << 30, WinA, DM, DM, DM}; pg8::StaticOrder S; S.init(MT, NCR, G, bx);
            pg8::EpiBf<0> E{PC, 1536, PR, RWC, 1536};
            pg8::gemm_phase<pg8::EpiBf<0>, pg8::StaticOrder, true>(lds, g, S, E, tid);
        } break;
        case 2: {
            const bf16* PC = WSP(bf16, WS_PC); const bf16* PR = WSP(bf16, WS_PR); bf16* CA = WSP(bf16, WS_CA);
            const float* cw = INP(9) + (size_t)l * 3 * DC; const float* stc = INP(2) + (size_t)l * NSB * 2 * DC;
            const int c0 = lane * 8;
            float w0[8], w1[8], w2[8];
#pragma unroll
            for (int e = 0; e < 8; ++e) { w0[e] = cw[c0 + e]; w1[e] = cw[512 + c0 + e]; w2[e] = cw[1024 + c0 + e]; }
            for (int m = gw; m < MT; m += NGW) {
                int pos, len, sb; row_info(m, pos, len, sb);
                float u0[8], u1[8], u2[8], bg[8];
                { const bf16* rp = PC + (size_t)m * 1536; const v4u xi = *(const GAS v4u*)(rp + c0), bb = *(const GAS v4u*)(rp + 512 + c0), cg = *(const GAS v4u*)(rp + 1024 + c0);
#pragma unroll
                  for (int e = 0; e < 4; ++e) { u2[2 * e] = pg8::bf_lo(xi[e]) * pg8::bf_lo(cg[e]); u2[2 * e + 1] = pg8::bf_hi(xi[e]) * pg8::bf_hi(cg[e]); bg[2 * e] = pg8::bf_lo(bb[e]); bg[2 * e + 1] = pg8::bf_hi(bb[e]); } }
                if (pos >= 1) { const bf16* rp = PC + (size_t)(m - 1) * 1536; const v4u xi = *(const GAS v4u*)(rp + c0), cg = *(const GAS v4u*)(rp + 1024 + c0);
#pragma unroll
                  for (int e = 0; e < 4; ++e) { u1[2 * e] = pg8::bf_lo(xi[e]) * pg8::bf_lo(cg[e]); u1[2 * e + 1] = pg8::bf_hi(xi[e]) * pg8::bf_hi(cg[e]); } }
                else {
#pragma unroll
                  for (int e = 0; e < 8; ++e) u1[e] = (sb >= 0) ? stc[(size_t)sb * 1024 + 512 + c0 + e] : 0.f; }
                if (pos >= 2) { const bf16* rp = PC + (size_t)(m - 2) * 1536; const v4u xi = *(const GAS v4u*)(rp + c0), cg = *(const GAS v4u*)(rp + 1024 + c0);
#pragma unroll
                  for (int e = 0; e < 4; ++e) { u0[2 * e] = pg8::bf_lo(xi[e]) * pg8::bf_lo(cg[e]); u0[2 * e + 1] = pg8::bf_hi(xi[e]) * pg8::bf_hi(cg[e]); } }
                else {
#pragma unroll
                  for (int e = 0; e < 8; ++e) u0[e] = (sb >= 0) ? stc[(size_t)sb * 1024 + (size_t)(pos == 1 ? 512 : 0) + c0 + e] : 0.f; }
                v4u o;
                { float y[8];
#pragma unroll
                  for (int e = 0; e < 8; ++e) y[e] = bg[e] * (w0[e] * u0[e] + w1[e] * u1[e] + w2[e] * u2[e]);
                  o.x = pk2(y[0], y[1]); o.y = pk2(y[2], y[3]); o.z = pk2(y[4], y[5]); o.w = pk2(y[6], y[7]); }
                *(GAS v4u*)(CA + (size_t)m * 512 + c0) = o;
                if (pos >= len - 2) {
                    const int j = pos - (len - 2);
                    float* dst = (sb < 0) ? out + O_CONVP + (size_t)l * 1024 + j * 512 + c0 : out + O_CONVS + ((size_t)(l * NSB + sb) * 2 + j) * 512 + c0;
                    *(GAS f32x4*)dst = (f32x4){u2[0], u2[1], u2[2], u2[3]}; *(GAS f32x4*)(dst + 4) = (f32x4){u2[4], u2[5], u2[6], u2[7]};
                    if (pos == len - 1) {
                        float* sd = (sb < 0) ? out + O_SHIFTP + (size_t)l * RWC : out + O_SHIFTS + (size_t)(l * NSB + sb) * RWC; const bf16* rp = PR + (size_t)m * RWC;
                        for (int c = lane; c < RWC; c += 64) sd[c] = bf2f(rp[c]);
                    }
                }
            }
        } break;
        case 3: {
            const bf16* PR = WSP(bf16, WS_PR); float* WD = WSP(float, WS_WD); _Float16* AL = WSP(_Float16, WS_AL); _Float16* GO = WSP(_Float16, WS_GO); const float* mu = INP(8) + (size_t)l * RWC;
            LAS float* xs = (LAS float*)lds; LAS float* wsm = (LAS float*)(lds + 65792);
            const float* wd2 = INP(11) + (size_t)l * 64 * 512; const float* a2 = INP(13) + (size_t)l * 64 * 512; const float* g2 = INP(14) + (size_t)l * 128 * 512;
            const float* wd0 = INP(10) + (size_t)l * 512; const float* a0 = INP(12) + (size_t)l * 512; const float* sts = INP(3) + (size_t)l * NSB * RWC;
            for (int it = bx; it < (MT / 64) * NH; it += G) {
                const int tile = it >> 3, h = it & 7, mb = tile * 64;
                for (int idx = tid; idx < 16384; idx += 512) {
                    const int tok = idx >> 8, c = idx & 255, m = mb + tok; int pos, len, sb; row_info(m, pos, len, sb);
                    const float cur = bf2f(PR[(size_t)m * RWC + 1536 + c]);
                    const float prv = (pos >= 1) ? bf2f(PR[(size_t)(m - 1) * RWC + 1536 + c]) : (sb >= 0 ? sts[(size_t)sb * RWC + 1536 + c] : 0.f);
                    float v = cur + (prv - cur) * mu[1536 + c];
                    if (c < 64) v = tanhf(v); else if (c >= 128) v = sigm(v);
                    xs[tok * 257 + c] = v;
                }
                for (int idx = tid; idx < 16384; idx += 512) {
                    const int kk = idx >> 6, c = idx & 63;
                    wsm[idx] = (kk < 64) ? wd2[(size_t)kk * 512 + 64 * h + c] : (kk < 128) ? a2[(size_t)(kk - 64) * 512 + 64 * h + c] : g2[(size_t)(kk - 128) * 512 + 64 * h + c];
                }
                __syncthreads();
                const int tok = tid & 63, cg = wave;
                f32x4 ad[2] = {{0, 0, 0, 0}, {0, 0, 0, 0}}, aa[2] = {{0, 0, 0, 0}, {0, 0, 0, 0}}, ag[2] = {{0, 0, 0, 0}, {0, 0, 0, 0}};
                const LAS float* xr = xs + tok * 257; const LAS float* wr_ = wsm + 8 * cg;
#pragma unroll 4
                for (int kk = 0; kk < 64; ++kk) { const float x = xr[kk]; ad[0] += *(const LAS f32x4*)(wr_ + kk * 64) * x; ad[1] += *(const LAS f32x4*)(wr_ + kk * 64 + 4) * x; }
#pragma unroll 4
                for (int kk = 64; kk < 128; ++kk) { const float x = xr[kk]; aa[0] += *(const LAS f32x4*)(wr_ + kk * 64) * x; aa[1] += *(const LAS f32x4*)(wr_ + kk * 64 + 4) * x; }
#pragma unroll 4
                for (int kk = 128; kk < 256; ++kk) { const float x = xr[kk]; ag[0] += *(const LAS f32x4*)(wr_ + kk * 64) * x; ag[1] += *(const LAS f32x4*)(wr_ + kk * 64 + 4) * x; }
                const int m = mb + tok, cb = 64 * h + 8 * cg;
                float dec[8]; _Float16 alh[8], goh[8];
#pragma unroll
                for (int e = 0; e < 8; ++e) {
                    const float wraw = wd0[cb + e] + ad[e >> 2][e & 3];
                    const float z = -wraw, sp = fmaxf(z, 0.f) + log1pf(__expf(-fabsf(z)));
                    dec[e] = __expf(-__expf(-sp - 0.5f));
                    alh[e] = (_Float16)sigm(a0[cb + e] + aa[e >> 2][e & 3]);
                    goh[e] = (_Float16)ag[e >> 2][e & 3];
                }
                *(GAS f32x4*)(WD + (size_t)m * 512 + cb) = (f32x4){dec[0], dec[1], dec[2], dec[3]}; *(GAS f32x4*)(WD + (size_t)m * 512 + cb + 4) = (f32x4){dec[4], dec[5], dec[6], dec[7]};
#pragma unroll
                for (int e = 0; e < 8; ++e) { AL[(size_t)m * 512 + cb + e] = alh[e]; GO[(size_t)m * 512 + cb + e] = goh[e]; }
                __syncthreads();
            }
        } break;
        case 4: case 6: {
            float* PQ = WSP(float, WS_PQ); float* SS = WSP(float, WS_SS);
            ScanCtx C; C.PR = WSP(bf16, WS_PR); C.WD = WSP(float, WS_WD); C.AL = WSP(_Float16, WS_AL); C.GO = WSP(_Float16, WS_GO); C.YB = WSP(bf16, WS_YB); C.mu = INP(8) + (size_t)l * RWC; C.k_k = INP(15) + (size_t)l * 512; C.k_a = INP(16) + (size_t)l * 512;
            C.r_k = INP(17) + (size_t)l * 512; C.lnw = INP(18) + (size_t)l * 512; C.lnb = INP(19) + (size_t)l * 512;
            LAS float* st = (LAS float*)(lds + wave * 12352);
            if (k == 4) {
                for (int it = gw; it < (NCH - 1) * NH * 2; it += NGW) {
                    const int kind = it & 1, h = (it >> 1) & 7, c = it >> 4;
                    float* o = PQ + ((size_t)(c * NH + h) * 2 + kind) * 4096;
                    if (kind == 0) scan_task<0>(C, st, lane, h, c * CH, CH, nullptr, c > 0, nullptr, nullptr, o);
                    else scan_task<1>(C, st, lane, h, c * CH, CH, nullptr, c > 0, nullptr, nullptr, o);
                }
            } else {
                const float* sts = INP(3) + (size_t)l * NSB * RWC; const float* stw = INP(4) + (size_t)l * NSB * NH * 4096;
                for (int it = gw; it < NCH * NH + NSB * NH; it += NGW) {
                    if (it < NCH * NH) { const int h = it & 7, c = it >> 3;
                        scan_task<2>(C, st, lane, h, c * CH, CH, nullptr, c > 0, nullptr, c > 0 ? SS + (size_t)(c * NH + h) * 4096 : nullptr,
                                     c == NCH - 1 ? out + O_WKVP + (size_t)(l * NH + h) * 4096 : nullptr);
                    } else { const int j = it - NCH * NH, h = j & 7, b = j >> 3;
                        scan_task<2>(C, st, lane, h, TP + 64 * b, TS, sts + (size_t)b * RWC, false, stw + (size_t)(b * NH + h) * 4096, nullptr, out + O_WKVS + (size_t)((l * NSB + b) * NH + h) * 4096);
                    }
                }
            }
        } break;
        case 5: {
            if (bx < NH) {
                float* PQ = WSP(float, WS_PQ); float* SS = WSP(float, WS_SS);
                const int h = bx;
                LAS unsigned char* AF = lds;
                LAS unsigned char* BF = lds + 32768;
                const int hh = lane >> 5, mm = lane & 31;
                if (wave >= 4) {
                    for (int c = 0; c < NCH - 1; ++c) {
                        if (c + 1 < NCH - 1) {
                            const float* P = PQ + ((size_t)((c + 1) * NH + h) * 2 + 0) * 4096;
#pragma unroll
                            for (int ff = 0; ff < 2; ++ff) { const int f = 2 * (wave - 4) + ff, kt = f >> 2, s = (f >> 1) & 1, mt = f & 1;
                                float v[8];
#pragma unroll
                                for (int j = 0; j < 8; ++j) { const int kk = 32 * kt + 16 * s + 8 * (j >> 2) + 4 * hh + (j & 3); v[j] = P[kk * 64 + 32 * mt + mm]; }
                                v4u hi, lo; unsigned hb[8];
#pragma unroll
                                for (int j = 0; j < 8; ++j) { hb[j] = f2bf(v[j]); v[j] -= __uint_as_float(hb[j] << 16); }
                                hi.x = hb[0] | (hb[1] << 16); hi.y = hb[2] | (hb[3] << 16); hi.z = hb[4] | (hb[5] << 16); hi.w = hb[6] | (hb[7] << 16);
                                lo.x = pk2(v[0], v[1]); lo.y = pk2(v[2], v[3]); lo.z = pk2(v[4], v[5]); lo.w = pk2(v[6], v[7]);
                                LAS unsigned char* dst = AF + ((c + 1) & 1) * 16384 + f * 2048 + lane * 16;
                                *(LAS v4u*)dst = hi; *(LAS v4u*)(dst + 1024) = lo; }
                        }
                        __syncthreads();
                    }
                } else {
                    const int mt = wave >> 1, nt = wave & 1;
                    f32x16 d;
                    for (int c = 0; c < NCH - 1; ++c) {
                        const float* QT = PQ + ((size_t)(c * NH + h) * 2 + 1) * 4096;
#pragma unroll
                        for (int r = 0; r < 16; ++r) d[r] = QT[(32 * mt + (r & 3) + 8 * (r >> 2) + 4 * hh) * 64 + 32 * nt + mm];
                        if (c > 0) {
#pragma unroll
                            for (int kt = 0; kt < 2; ++kt)
#pragma unroll
                                for (int s = 0; s < 2; ++s) {
                                    const LAS unsigned char* ap = AF + (c & 1) * 16384 + (((kt * 2 + s) * 2 + mt) * 2048) + lane * 16;
                                    const LAS unsigned char* bp = BF + (c & 1) * 16384 + (((kt * 2 + nt) * 2 + s) * 2048) + lane * 16;
                                    const bf16x8 ah = *(const LAS bf16x8*)ap, al = *(const LAS bf16x8*)(ap + 1024), bh = *(const LAS bf16x8*)bp, bl = *(const LAS bf16x8*)(bp + 1024);
                                    d = __builtin_amdgcn_mfma_f32_32x32x16_bf16(ah, bh, d, 0, 0, 0);
                                    d = __builtin_amdgcn_mfma_f32_32x32x16_bf16(al, bh, d, 0, 0, 0);
                                    d = __builtin_amdgcn_mfma_f32_32x32x16_bf16(ah, bl, d, 0, 0, 0);
                                }
                        }
                        float* So = SS + (size_t)((c + 1) * NH + h) * 4096;
#pragma unroll
                        for (int r = 0; r < 16; ++r) So[(32 * mt + (r & 3) + 8 * (r >> 2) + 4 * hh) * 64 + 32 * nt + mm] = d[r];
#pragma unroll
                        for (int s = 0; s < 2; ++s) { unsigned hb[8]; float v[8];
#pragma unroll
                            for (int j = 0; j < 8; ++j) { v[j] = d[8 * s + j]; hb[j] = f2bf(v[j]); v[j] -= __uint_as_float(hb[j] << 16); }
                            v4u hi, lo;
                            hi.x = hb[0] | (hb[1] << 16); hi.y = hb[2] | (hb[3] << 16); hi.z = hb[4] | (hb[5] << 16); hi.w = hb[6] | (hb[7] << 16);
                            lo.x = pk2(v[0], v[1]); lo.y = pk2(v[2], v[3]); lo.z = pk2(v[4], v[5]); lo.w = pk2(v[6], v[7]);
                            LAS unsigned char* dst = BF + ((c + 1) & 1) * 16384 + (((mt * 2 + nt) * 2 + s) * 2048) + lane * 16;
                            *(LAS v4u*)dst = hi; *(LAS v4u*)(dst + 1024) = lo; }
                        __syncthreads();
                    }
                }
            }
        } break;
        case 7: {
            bf16* XB = WSP(bf16, WS_XB); bf16* WinG = WSP(bf16, W_ING); bf16* GATES = WSP(bf16, WS_GATES);
            pg8::Gemm g{XB, XB, 1 << 30, WinG, DM, DM, DM}; pg8::StaticOrder S; S.init(MT, NGATE, G, bx);
            pg8::EpiBf<1> E{GATES, 2048, nullptr, 0, 0};
            pg8::gemm_phase<pg8::EpiBf<1>, pg8::StaticOrder, true>(lds, g, S, E, tid);
        } break;
        case 8: {
            bf16* CA = WSP(bf16, WS_CA); bf16* YB = WSP(bf16, WS_YB); bf16* Wcr = WSP(bf16, W_CR); bf16* GATES = WSP(bf16, WS_GATES);
            pg8::Gemm g{CA, YB, 4, Wcr, 512, 512, 512}; pg8::StaticOrder S; S.init(MT, 2048, G, bx);
            pg8::EpiBf<2> E{GATES, 2048, nullptr, 0, 0};
            pg8::gemm_phase<pg8::EpiBf<2>, pg8::StaticOrder, true>(lds, g, S, E, tid);
        } break;
        case 9: {
            bf16* GATES = WSP(bf16, WS_GATES); bf16* Wo2 = WSP(bf16, W_O2); float* MOUT = WSP(float, WS_MOUT);
            pg8::Gemm g{GATES, GATES, 1 << 30, Wo2, 2048, 2048, 2048}; pg8::StaticOrder S; S.init(MT, DM, G, bx);
            pg8::EpiF32 E{MOUT, DM};
            pg8::gemm_phase<pg8::EpiF32, pg8::StaticOrder, true>(lds, g, S, E, tid);
        } break;
        case 10: {
            const float* MOUT = WSP(float, WS_MOUT); bf16* XB = WSP(bf16, WS_XB); bf16* Wup = WSP(bf16, W_UP); bf16* Wdn = WSP(bf16, W_DN); const float* x_prompt = INP(0); const float* x_sample = INP(1);
            const float* g1 = INP(6) + (size_t)l * DM; const float* g2 = INP(23) + (size_t)l * DM;
            for (int m = gw; m < MT; m += NGW) {
                const float* xin = (l == 0) ? ((m < TP) ? x_prompt + (size_t)m * DM : x_sample + (size_t)(m - TP) * DM) : out + (size_t)m * DM;
                resid_norm_row(MOUT + (size_t)m * DM, xin, g1, out + (size_t)m * DM, g2, XB + (size_t)m * DM, lane);
            }
            LAS float* scr = (LAS float*)(lds + wave * 16384);
            const float* wup = INP(25) + (size_t)l * DM * 2 * DFF; const float* wdn = INP(26) + (size_t)l * DFF * DM;
            constexpr int I_UP = 16 * (2 * DFF / 32), I_DN = (DFF / 64) * 32;
            for (int it = gw; it < I_UP + I_DN; it += NGW) {
                if (it < I_UP) { const int nb = it % (2 * DFF / 32), kb = it / (2 * DFF / 32), n0 = nb * 32;
                    const int f = (n0 < DFF) ? n0 : n0 - DFF; const int drow = 256 * (f / 128) + (n0 < DFF ? 0 : 128) + (f % 128);
                    transpose_item(wup + n0, 2 * DFF, kb * 64, 0, Wup, DM, drow, 0, scr, lane);
                } else { const int r = it - I_UP; transpose_item(wdn, DM, (r / 32) * 64, (r % 32) * 32, Wdn, DFF, 0, 0, scr, lane); }
            }
        } break;
        case 11: {
            bf16* XB = WSP(bf16, WS_XB); bf16* Wup = WSP(bf16, W_UP); bf16* HB = WSP(bf16, WS_H);
            pg8::Gemm g{XB, XB, 1 << 30, Wup, DM, DM, DM}; pg8::StaticOrder S; S.init(MT, 2 * DFF, G, bx);
            pg8::EpiSwiglu E{HB, DFF};
            pg8::gemm_phase<pg8::EpiSwiglu, pg8::StaticOrder, true>(lds, g, S, E, tid);
        } break;
        case 12: {
            bf16* HB = WSP(bf16, WS_H); bf16* Wdn = WSP(bf16, W_DN); float* FOUT = WSP(float, WS_FOUT);
            pg8::Gemm g{HB, HB, 1 << 30, Wdn, DFF, DFF, DFF}; pg8::StaticOrder S; S.init(MT, DM, G, bx);
            pg8::EpiF32 E{FOUT, DM};
            pg8::gemm_phase<pg8::EpiF32, pg8::StaticOrder, true>(lds, g, S, E, tid);
        } break;
        case 13: {
            const float* FOUT = WSP(float, WS_FOUT); bf16* XB = WSP(bf16, WS_XB);
            const float* g1 = INP(24) + (size_t)l * DM; const float* g2 = (l + 1 < DEPTH) ? INP(5) + (size_t)(l + 1) * DM : nullptr;
            for (int m = gw; m < MT; m += NGW) resid_norm_row(FOUT + (size_t)m * DM, out + (size_t)m * DM, g1, out + (size_t)m * DM, g2, XB + (size_t)m * DM, lane);
        } break;
        }
        if (ph + 1 < hi) { if (!MK_PER_PHASE) xcd_barrier(bar); else __syncthreads(); }
    }
}

extern "C" void kernel_launch(void* const* d_in, const int* in_sizes, int n_in, void* d_out, int out_size, void* d_ws, size_t ws_size, hipStream_t stream) {
    static int grid = 0;
    if (grid == 0) {
        if (n_in != 27 || out_size != (int)O_END || ws_size < WS_END) { fprintf(stderr, "kernel_launch: unexpected shapes: n_in %d out %d ws %zu\n", n_in, out_size, ws_size); grid = -1; return; }
        int dev = 0, cus = 0;
        if (hipGetDevice(&dev) != hipSuccess || hipDeviceGetAttribute(&cus, hipDeviceAttributeMultiprocessorCount, dev) != hipSuccess) { grid = -1; return; }
        if (hipFuncSetAttribute((const void*)mega, hipFuncAttributeMaxDynamicSharedMemorySize, LDS_BYTES) != hipSuccess) { fprintf(stderr, "kernel_launch: hipFuncSetAttribute failed\n"); grid = -1; return; }
        (void)hipGetLastError();
        grid = cus;
    }
    if (grid < 0) return;
    (void)hipMemsetAsync((char*)d_ws + WS_CTL, 0, CTL_ZERO_BYTES, stream);
    Args a{};
    for (int i = 0; i < 27; ++i) a.in[i] = (const float*)d_in[i];
    a.out = (float*)d_out; a.ws = (unsigned char*)d_ws;
#if MK_PER_PHASE
    for (int ph = 0; ph < N_PHASES; ++ph) { a.ph_lo = ph; a.ph_hi = ph + 1; hipLaunchKernelGGL(mega, dim3(grid), dim3(512), LDS_BYTES, stream, a); }
#else
    a.ph_lo = 0; a.ph_hi = N_PHASES;
    hipLaunchKernelGGL(mega, dim3(grid), dim3(512), LDS_BYTES, stream, a);
#endif
}
```

```cpp
#include <hip/hip_runtime.h>
#include <cstdio>
#include <cstdint>

#ifndef REP_MASK
#define REP_MASK 0
#endif
#ifndef MK_PER_PHASE
#define MK_PER_PHASE 0
#endif

namespace pg8 {
#define PG8_LAS __attribute__((address_space(3)))
typedef unsigned short bf16_t;
typedef short bf16x8 __attribute__((ext_vector_type(8)));
typedef float f32x4 __attribute__((ext_vector_type(4)));
typedef float f32x2 __attribute__((ext_vector_type(2)));
typedef unsigned u32x4 __attribute__((ext_vector_type(4)));
constexpr int BM = 256, BK = 64, HALF = 128, HTB = HALF * BK * 2, STAGE_BYTES = 8 * HTB, NXCD = 8, WGM = 8;

__host__ __device__ __forceinline__ int lds_byte(int r, int c) { const int st = (r >> 4) * 2 + (c >> 5), rr = r & 15, cc = c & 31, ob = rr * 64 + cc * 2; return st * 1024 + (ob ^ (((ob >> 9) & 1) << 5)); }
__host__ __device__ __forceinline__ void stage_rc(int b, int& R, int& C) { const int st = b / 1024, sb = b % 1024, swz = sb ^ (((sb >> 9) & 1) << 5); R = (st >> 1) * 16 + swz / 64; C = (st & 1) * 32 + (swz % 64) / 2; }
__host__ __device__ __forceinline__ int perm32(int rho) { const int n = rho >> 4, i = rho & 15; return 8 * (i >> 2) + 4 * n + (i & 3); }

struct Unit { int pm, pn; };
struct Gemm { const bf16_t* A0; const bf16_t* A1; int split_pn; const bf16_t* Bt; int lda, ldb, K; };

struct StaticOrder {
    int nM, nN, nwg, G, c;
    __host__ __device__ void init(int M, int N, int G_, int c_) { nM = M / BM; nN = N / BM; nwg = nM * nN; G = G_; c = c_; }
    __host__ __device__ bool next(int i, Unit& u) const {
        const long L = (long)i * G + c; if (L >= nwg) return false;
        int wgid = (int)L; { const int q = nwg / NXCD, r = nwg % NXCD, xcd = wgid % NXCD, off = wgid / NXCD; wgid = (xcd < r ? xcd * (q + 1) : r * (q + 1) + (xcd - r) * q) + off; }
        const int nig = WGM * nN, gid = wgid / nig, fm = gid * WGM, gsz = (nM - fm) < WGM ? (nM - fm) : WGM;
        u.pm = fm + ((wgid % nig) % gsz); u.pn = (wgid % nig) / gsz; return true;
    }
};

__device__ __forceinline__ unsigned cvt_pk_bf16(float lo, float hi) { unsigned r; asm volatile("v_cvt_pk_bf16_f32 %0, %1, %2" : "=v"(r) : "v"(lo), "v"(hi)); return r; }
__device__ __forceinline__ float bf_lo(unsigned w) { return __uint_as_float(w << 16); }
__device__ __forceinline__ float bf_hi(unsigned w) { return __uint_as_float(w & 0xffff0000u); }
__device__ __forceinline__ float sigmoidf_(float x) { return 1.0f / (1.0f + __expf(-x)); }

struct EpiF32 {
    static constexpr bool PERM = false;
    float* C; int ldc;
    __device__ __forceinline__ void operator()(const f32x4 (&acc)[2][2][4][2], const Unit& u, int wr, int wc, int fr, int fq) const {
        const int row0 = u.pm * BM + wr * 64 + fr, col0 = u.pn * BM + wc * 32 + 4 * fq;
#pragma unroll
        for (int ai = 0; ai < 2; ++ai)
#pragma unroll
            for (int m = 0; m < 4; ++m) { float* rowp = C + (size_t)(row0 + ai * HALF + m * 16) * ldc + col0;
#pragma unroll
                for (int bj = 0; bj < 2; ++bj)
#pragma unroll
                    for (int n = 0; n < 2; ++n) *(f32x4*)(rowp + bj * HALF + n * 16) = acc[ai][bj][m][n]; }
    }
};
template <int MODE> struct EpiBf {
    static constexpr bool PERM = true;
    bf16_t* O0; int ld0; bf16_t* O1; int ld1; int split;
    __device__ __forceinline__ void operator()(const f32x4 (&acc)[2][2][4][2], const Unit& u, int wr, int wc, int fr, int fq) const {
        const int row0 = u.pm * BM + wr * 64 + fr; int colt = u.pn * BM; bf16_t* base = O0; int ldc = ld0;
        if (MODE == 0 && colt >= split) { base = O1; ldc = ld1; colt -= split; }
        const int col0 = colt + wc * 32 + 8 * fq;
#pragma unroll
        for (int ai = 0; ai < 2; ++ai)
#pragma unroll
            for (int m = 0; m < 4; ++m) { bf16_t* rowp = base + (size_t)(row0 + ai * HALF + m * 16) * ldc + col0;
#pragma unroll
                for (int bj = 0; bj < 2; ++bj) { f32x4 v0 = acc[ai][bj][m][0], v1 = acc[ai][bj][m][1];
                    if (MODE == 1) {
#pragma unroll
                        for (int e = 0; e < 4; ++e) { v0[e] = sigmoidf_(v0[e]); v1[e] = sigmoidf_(v1[e]); } }
                    if (MODE == 2) { const u32x4 gw = *(const u32x4*)(rowp + bj * HALF);
                        v0[0] *= bf_lo(gw.x); v0[1] *= bf_hi(gw.x); v0[2] *= bf_lo(gw.y); v0[3] *= bf_hi(gw.y);
                        v1[0] *= bf_lo(gw.z); v1[1] *= bf_hi(gw.z); v1[2] *= bf_lo(gw.w); v1[3] *= bf_hi(gw.w); }
                    u32x4 w; w.x = cvt_pk_bf16(v0[0], v0[1]); w.y = cvt_pk_bf16(v0[2], v0[3]); w.z = cvt_pk_bf16(v1[0], v1[1]); w.w = cvt_pk_bf16(v1[2], v1[3]);
                    *(u32x4*)(rowp + bj * HALF) = w; } }
    }
};
struct EpiSwiglu {
    static constexpr bool PERM = true;
    bf16_t* H; int ldc;
    __device__ __forceinline__ void operator()(const f32x4 (&acc)[2][2][4][2], const Unit& u, int wr, int wc, int fr, int fq) const {
        const int row0 = u.pm * BM + wr * 64 + fr, col0 = u.pn * HALF + wc * 32 + 8 * fq;
#pragma unroll
        for (int ai = 0; ai < 2; ++ai)
#pragma unroll
            for (int m = 0; m < 4; ++m) { bf16_t* rowp = H + (size_t)(row0 + ai * HALF + m * 16) * ldc + col0;
                f32x4 v0 = acc[ai][0][m][0], v1 = acc[ai][0][m][1]; const f32x4 g0 = acc[ai][1][m][0], g1 = acc[ai][1][m][1];
#pragma unroll
                for (int e = 0; e < 4; ++e) { v0[e] = v0[e] * sigmoidf_(v0[e]) * g0[e]; v1[e] = v1[e] * sigmoidf_(v1[e]) * g1[e]; }
                u32x4 w; w.x = cvt_pk_bf16(v0[0], v0[1]); w.y = cvt_pk_bf16(v0[2], v0[3]); w.z = cvt_pk_bf16(v1[0], v1[1]); w.w = cvt_pk_bf16(v1[2], v1[3]);
                *(u32x4*)rowp = w; }
    }
};

typedef _Float16 half8 __attribute__((ext_vector_type(8)));
struct EpiLora {
    static constexpr bool PERM = true;
    unsigned char* ws; size_t owd, oal, ogo; const float* wd0; const float* a0;
    __device__ __forceinline__ void operator()(const f32x4 (&acc)[2][2][4][2], const Unit& u, int wr, int wc, int fr, int fq) const {
        const int row0 = u.pm * BM + wr * 64 + fr, colt = u.pn * BM, seg = colt >> 9, cb = (colt & 511) + wc * 32 + 8 * fq;
        float* WD = (float*)(ws + owd); _Float16* AL = (_Float16*)(ws + oal); _Float16* GO = (_Float16*)(ws + ogo);
#pragma unroll
        for (int bj = 0; bj < 2; ++bj) {
            f32x4 c00 = (f32x4){0.f, 0.f, 0.f, 0.f}, c01 = c00;
            if (seg == 0) { c00 = *(const f32x4*)(wd0 + cb + bj * HALF); c01 = *(const f32x4*)(wd0 + cb + bj * HALF + 4); }
            else if (seg == 1) { c00 = *(const f32x4*)(a0 + cb + bj * HALF); c01 = *(const f32x4*)(a0 + cb + bj * HALF + 4); }
#pragma unroll
            for (int ai = 0; ai < 2; ++ai)
#pragma unroll
                for (int m = 0; m < 4; ++m) { const size_t ro = (size_t)(row0 + ai * HALF + m * 16) * 512 + cb;
                    f32x4 v0 = acc[ai][bj][m][0] + c00, v1 = acc[ai][bj][m][1] + c01;
                    if (seg < 2) {
#pragma unroll
                        for (int e = 0; e < 4; ++e) { v0[e] = sigmoidf_(v0[e]); v1[e] = sigmoidf_(v1[e]); } }
                    if (seg == 0) {
#pragma unroll
                        for (int e = 0; e < 4; ++e) { v0[e] = __expf(-0.60653065971f * v0[e]); v1[e] = __expf(-0.60653065971f * v1[e]); }
                        *(f32x4*)(WD + ro + bj * HALF) = v0; *(f32x4*)(WD + ro + bj * HALF + 4) = v1;
                    } else {
                        half8 hv;
#pragma unroll
                        for (int e = 0; e < 4; ++e) { hv[e] = (_Float16)v0[e]; hv[4 + e] = (_Float16)v1[e]; }
                        *(half8*)((seg == 1 ? AL : GO) + ro + bj * HALF) = hv;
                    }
                    asm volatile("" ::: "memory");
                    {
                    } }
        }
    }
};

template <class Epi, class Sched, bool ALIGN_EPI>
__device__ __forceinline__ void gemm_phase(PG8_LAS unsigned char* lds, const Gemm g, const Sched& S, const Epi& E, const int tid) {
    const int wid = __builtin_amdgcn_readfirstlane(tid >> 6), lane = tid & 63, wr = wid >> 2, wc = wid & 3, fr = lane & 15, fq = lane >> 4;
    const int K = g.K, nt = K / BK;
    unsigned voffA[2], voffB[2];
#pragma unroll
    for (int i = 0; i < 2; ++i) { int R, C; stage_rc(tid * 16 + i * 8192, R, C); const int Rb = Epi::PERM ? ((R & ~31) + perm32(R & 31)) : R;
        voffA[i] = (unsigned)(R * g.lda + C) * 2u; voffB[i] = (unsigned)(Rb * g.ldb + C) * 2u; }
    const size_t kstep = (size_t)(BK * 2);
    const size_t hstepA = (size_t)HALF * g.lda * 2, hstepB = (size_t)HALF * g.ldb * 2;
    const size_t tstepA = 2 * hstepA, tstepB = 2 * hstepB;
    const unsigned ldsw = (unsigned)wid * 1024u;
    const int aoff = lds_byte(wr * 64 + fr, fq * 8), boff = lds_byte(wc * 32 + fr, fq * 8);
#define PG8_SA(b, h) (((b) * 2 + (h)) * HTB)
#define PG8_SB(b, h) ((4 + (b) * 2 + (h)) * HTB)
#define PG8_STAGE(bufoff, gbase, voff) do { _Pragma("unroll") for (int _i = 0; _i < 2; ++_i) \
        __builtin_amdgcn_global_load_lds((const unsigned*)((const char*)(gbase) + (voff)[_i]), (PG8_LAS unsigned*)(lds + (bufoff) + ldsw + _i * 8192), 16, 0, 0); } while (0)
#define PG8_LDA(dst, b, h) do { _Pragma("unroll") for (int m = 0; m < 4; ++m) _Pragma("unroll") for (int k = 0; k < 2; ++k) dst[m][k] = *(const PG8_LAS bf16x8*)(lds + PG8_SA(b, h) + aoff + m * 2048 + k * 1024); } while (0)
#define PG8_LDB(dst, b, h) do { _Pragma("unroll") for (int n = 0; n < 2; ++n) _Pragma("unroll") for (int k = 0; k < 2; ++k) dst[n][k] = *(const PG8_LAS bf16x8*)(lds + PG8_SB(b, h) + boff + n * 2048 + k * 1024); } while (0)
#define PG8_MMA(ai, bj, At, Bt) do { __builtin_amdgcn_s_setprio(1); _Pragma("unroll") for (int m = 0; m < 4; ++m) _Pragma("unroll") for (int n = 0; n < 2; ++n) _Pragma("unroll") for (int k = 0; k < 2; ++k) \
        acc[ai][bj][m][n] = __builtin_amdgcn_mfma_f32_16x16x32_bf16(Bt[n][k], At[m][k], acc[ai][bj][m][n], 0, 0, 0); __builtin_amdgcn_s_setprio(0); } while (0)
#define PG8_WAIT_V(n) asm volatile("s_waitcnt vmcnt(" #n ")" ::: "memory")
#define PG8_WAIT_L(n) asm volatile("s_waitcnt lgkmcnt(" #n ")" ::: "memory")
#define PG8_BAR __builtin_amdgcn_s_barrier()
#define PG8_SCHED __builtin_amdgcn_sched_barrier(0)
#define PG8_APTR(u) ((const char*)((u).pn < g.split_pn ? g.A0 : g.A1) + (size_t)(u).pm * tstepA)
#define PG8_BPTR(u) ((const char*)g.Bt + (size_t)(u).pn * tstepB)
    Unit cur, nxt; int ui = 0;
    if (!S.next(0, cur)) return;
    f32x4 acc[2][2][4][2];
#pragma unroll
    for (int a = 0; a < 2; ++a)
#pragma unroll
        for (int b = 0; b < 2; ++b)
#pragma unroll
            for (int m = 0; m < 4; ++m)
#pragma unroll
                for (int n = 0; n < 2; ++n) acc[a][b][m][n] = (f32x4){0.f, 0.f, 0.f, 0.f};
    bf16x8 At[4][2], B0[2][2], B1[2][2];
    const char* cA = PG8_APTR(cur); const char* cB = PG8_BPTR(cur);
    PG8_STAGE(PG8_SB(0, 0), cB, voffB); PG8_STAGE(PG8_SB(0, 1), cB + hstepB, voffB); PG8_STAGE(PG8_SA(0, 0), cA, voffA); PG8_STAGE(PG8_SA(0, 1), cA + hstepA, voffA);
    if (wr == 1) PG8_BAR;
    PG8_WAIT_V(2); PG8_BAR;
    PG8_STAGE(PG8_SB(1, 0), cB + kstep, voffB); PG8_STAGE(PG8_SA(1, 0), cA + kstep, voffA); PG8_STAGE(PG8_SB(1, 1), cB + hstepB + kstep, voffB);
    PG8_WAIT_V(6); PG8_BAR;
    for (;;) {
        const bool has_next = S.next(ui + 1, nxt);
        const char* nA = has_next ? PG8_APTR(nxt) : cA; const char* nB = has_next ? PG8_BPTR(nxt) : cB;
        for (int t = 0; t < nt; t += 2) {
            const bool last = (t == nt - 2);
            const char* a1 = cA + (size_t)(t + 1) * kstep;
            const char* a2 = last ? nA : cA + (size_t)(t + 2) * kstep; const char* b2 = last ? nB : cB + (size_t)(t + 2) * kstep;
            const char* a3 = a2 + kstep; const char* b3 = b2 + kstep;
            PG8_LDB(B0, 0, 0); PG8_LDB(B1, 0, 1); PG8_SCHED; PG8_LDA(At, 0, 0); PG8_STAGE(PG8_SA(1, 1), a1 + hstepA, voffA);
            PG8_WAIT_V(8); PG8_WAIT_L(0); PG8_BAR; PG8_MMA(0, 0, At, B0); PG8_MMA(0, 1, At, B1); PG8_BAR; PG8_SCHED;
            PG8_LDA(At, 0, 1); PG8_STAGE(PG8_SB(0, 0), b2, voffB); PG8_STAGE(PG8_SB(0, 1), b2 + hstepB, voffB); PG8_STAGE(PG8_SA(0, 0), a2, voffA);
            PG8_WAIT_V(8); PG8_WAIT_L(0); PG8_BAR; PG8_MMA(1, 0, At, B0); PG8_MMA(1, 1, At, B1); PG8_BAR; PG8_SCHED;
            PG8_LDB(B0, 1, 0); PG8_LDB(B1, 1, 1); PG8_SCHED; PG8_LDA(At, 1, 0); PG8_STAGE(PG8_SA(0, 1), a2 + hstepA, voffA);
            PG8_WAIT_V(8); PG8_WAIT_L(0); PG8_BAR; PG8_MMA(0, 0, At, B0); PG8_MMA(0, 1, At, B1); PG8_BAR; PG8_SCHED;
            PG8_LDA(At, 1, 1); PG8_STAGE(PG8_SB(1, 0), b3, voffB); PG8_STAGE(PG8_SB(1, 1), b3 + hstepB, voffB); PG8_STAGE(PG8_SA(1, 0), a3, voffA);
            PG8_WAIT_V(8); PG8_WAIT_L(0); PG8_BAR; PG8_MMA(1, 0, At, B0); PG8_MMA(1, 1, At, B1); PG8_BAR; PG8_SCHED;
        }
        if constexpr (ALIGN_EPI) { if (wr == 0) PG8_BAR; }
        E(acc, cur, wr, wc, fr, fq);
        if (!has_next) break;
#pragma unroll
        for (int a = 0; a < 2; ++a)
#pragma unroll
            for (int b = 0; b < 2; ++b)
#pragma unroll
                for (int m = 0; m < 4; ++m)
#pragma unroll
                    for (int n = 0; n < 2; ++n) acc[a][b][m][n] = (f32x4){0.f, 0.f, 0.f, 0.f};
        cur = nxt; cA = nA; cB = nB; ++ui;
        if constexpr (ALIGN_EPI) { if (wr == 1) PG8_BAR; }
    }
    PG8_WAIT_V(0);
    if constexpr (!ALIGN_EPI) { if (wr == 0) PG8_BAR; }
    PG8_BAR;
#undef PG8_SA
#undef PG8_SB
#undef PG8_STAGE
#undef PG8_LDA
#undef PG8_LDB
#undef PG8_MMA
#undef PG8_WAIT_V
#undef PG8_WAIT_L
#undef PG8_BAR
#undef PG8_SCHED
#undef PG8_APTR
#undef PG8_BPTR
}
}

constexpr int DM = 1024, TP = 16384, NSB = 32, TS = 64, MT = TP + NSB * TS;
constexpr int DEPTH = 2, DC = 512, DR = 512, NH = 8, HS = 64;
constexpr int RWC = 1792, NCR = 3328, NGATE = 2048, INC = 5376, DFF = 2816;
constexpr int CH = 128, NCH = TP / CH;
constexpr float RMS_EPS = 1e-6f, LNX_EPS = 64e-5f;

constexpr size_t MiB = 1u << 20;
constexpr size_t WS_CTL = 0, CTL_ZERO_BYTES = 64 * 1024;
constexpr size_t WS_W = 1 * MiB;
constexpr size_t W_INA = WS_W, W_ING = W_INA + (size_t)NCR * DM * 2, W_CR = W_ING + (size_t)NGATE * DM * 2, W_O2 = W_CR + (size_t)2048 * 512 * 2;
constexpr size_t W_UP = WS_W, W_DN = W_UP + (size_t)2 * DFF * DM * 2;
constexpr size_t WS_SS = 18 * MiB;
constexpr size_t WS_XB = 34 * MiB;
constexpr size_t WS_PC = 70 * MiB;
constexpr size_t WS_WD = 70 * MiB, WS_AL = 106 * MiB;
constexpr size_t WS_PR = 124 * MiB;
constexpr size_t WS_CA = 187 * MiB;
constexpr size_t WS_GO = 205 * MiB;
constexpr size_t WS_PQ = 223 * MiB;
constexpr size_t WS_YB = 223 * MiB;
constexpr size_t WS_XL = 223 * MiB, WS_WL = 233 * MiB;
constexpr size_t WS_GATES = 70 * MiB;
constexpr size_t WS_MOUT = 142 * MiB;
constexpr size_t WS_H = 70 * MiB;
constexpr size_t WS_FOUT = 169 * MiB;
constexpr size_t WS_END = 256 * MiB;
static_assert(W_O2 + (size_t)1024 * 2048 * 2 <= WS_SS && W_DN + (size_t)DM * DFF * 2 <= WS_SS, "weights");
static_assert(WS_SS + (size_t)NCH * NH * 16384 <= WS_XB && WS_XB + (size_t)MT * DM * 2 <= WS_PC && WS_PC + (size_t)MT * 1536 * 2 <= WS_PR && WS_PR + (size_t)MT * RWC * 2 <= WS_CA, "map1");
static_assert(WS_CA + (size_t)MT * 512 * 2 <= WS_GO && WS_GO + (size_t)MT * 512 * 2 <= WS_PQ && WS_PQ + (size_t)NCH * NH * 32768 <= WS_END, "map2");
static_assert(WS_WD + (size_t)MT * 512 * 4 <= WS_AL && WS_AL + (size_t)MT * 512 * 2 <= WS_PR, "map3");
static_assert(WS_GATES + (size_t)MT * 2048 * 2 <= WS_MOUT && WS_MOUT + (size_t)MT * DM * 4 <= WS_PQ && WS_H + (size_t)MT * DFF * 2 <= WS_FOUT && WS_FOUT + (size_t)MT * DM * 4 <= WS_END, "map4");
constexpr int CW_BAR = 4096;

constexpr size_t O_Y = 0, O_CONVP = (size_t)MT * DM, O_SHIFTP = O_CONVP + 2 * 2 * 512, O_WKVP = O_SHIFTP + 2 * RWC, O_CONVS = O_WKVP + 2 * 8 * 4096,
                 O_SHIFTS = O_CONVS + (size_t)2 * 32 * 2 * 512, O_WKVS = O_SHIFTS + (size_t)2 * 32 * RWC, O_END = O_WKVS + (size_t)2 * 32 * 8 * 4096;

constexpr int RING_BYTES = 131072, MISC_OFF = RING_BYTES + 320, LDS_BYTES = 147456;

#define GAS __attribute__((address_space(1)))
#define LAS __attribute__((address_space(3)))
typedef unsigned short bf16;
typedef unsigned v4u __attribute__((ext_vector_type(4)));
typedef unsigned v2u __attribute__((ext_vector_type(2)));
typedef float f32x4 __attribute__((ext_vector_type(4)));
typedef float f32x16 __attribute__((ext_vector_type(16)));
typedef short bf16x8 __attribute__((ext_vector_type(8)));
typedef GAS unsigned gu32;
#define LDS_WAIT() asm volatile("s_waitcnt lgkmcnt(0)" ::: "memory")
#define VM_WAIT() asm volatile("s_waitcnt vmcnt(0)" ::: "memory")
__device__ __forceinline__ unsigned f2bf(float f) { unsigned u = __builtin_bit_cast(unsigned, f); return (u + 0x7fffu + ((u >> 16) & 1u)) >> 16; }
__device__ __forceinline__ unsigned pk2(float lo, float hi) { return f2bf(lo) | (f2bf(hi) << 16); }
__device__ __forceinline__ float bf2f(unsigned short b) { return __uint_as_float((unsigned)b << 16); }
__device__ __forceinline__ float sigm(float x) { return 1.0f / (1.0f + __expf(-x)); }

#define XB_TMO      128
#define XB_XCNT(j)  (256  + 64 * (j))
#define XB_XSUB(j)  (1280 + 64 * (j))
#define XB_XGEN(j)  (2304 + 64 * (j))
#define XB_TOP      3328
#define XB_TOPGEN   3392
#define XCD_BAR_WORDS 3456
#define XB_SPIN_CAP (1u << 18)
__device__ __forceinline__ unsigned xb_ld(unsigned* p)              { return __hip_atomic_load(p, __ATOMIC_RELAXED, __HIP_MEMORY_SCOPE_AGENT); }
__device__ __forceinline__ unsigned xb_add(unsigned* p, unsigned v) { return __hip_atomic_fetch_add(p, v, __ATOMIC_RELAXED, __HIP_MEMORY_SCOPE_AGENT); }
__device__ __forceinline__ unsigned xb_xcc_id() { return (unsigned)__builtin_amdgcn_s_getreg((3 << 11) | 20) & 0xFu; }
#define XB_SPIN(cond, bar) do { unsigned _sp = 0; while (cond) { __builtin_amdgcn_s_sleep(1); \
    if ((++_sp & 255u) == 0u) { if (xb_ld(&(bar)[XB_TMO])) break; if (_sp > XB_SPIN_CAP) { atomicAdd(&(bar)[XB_TMO], 1u); break; } } } } while (0)
struct XcdBarrier { unsigned* bar; unsigned x; volatile LAS unsigned* st; };
__device__ __forceinline__ XcdBarrier xcd_barrier_post(unsigned* bar, volatile LAS unsigned* st) {
    XcdBarrier b; b.bar = bar; b.x = xb_xcc_id(); b.st = st;
    if (threadIdx.x == 0) (void)xb_add(&bar[XB_XCNT(b.x)], 1u);
    return b;
}
__device__ __forceinline__ void xcd_barrier_complete(unsigned* bar, unsigned x, unsigned& nloc, unsigned& nx) {
    const unsigned G = gridDim.x * gridDim.y * gridDim.z;
    unsigned sum, cnt, mine, sp = 0u;
    for (;;) {
        sum = 0u; cnt = 0u; mine = 0u;
#pragma unroll
        for (unsigned j = 0; j < 16; ++j) { const unsigned c = xb_ld(&bar[XB_XCNT(j)]); sum += c; cnt += (c > 0u) ? 1u : 0u; mine = (j == x) ? c : mine; }
        if (sum == G) break;
        __builtin_amdgcn_s_sleep(1);
        if ((++sp & 255u) == 0u) { if (xb_ld(&bar[XB_TMO])) break; if (sp > XB_SPIN_CAP) { atomicAdd(&bar[XB_TMO], 1u); break; } }
    }
    nloc = mine > 0u ? mine : 1u; nx = cnt > 0u ? cnt : 1u;
}
__device__ __forceinline__ void xcd_barrier(const XcdBarrier& b) {
    asm volatile("s_waitcnt vmcnt(0)" ::: "memory");
    __syncthreads();
    if (threadIdx.x == 0) {
        unsigned* bar = b.bar;
        __builtin_amdgcn_s_waitcnt(0);
        unsigned nloc = b.st[0], nx = b.st[1];
        if (nloc == 0u) { xcd_barrier_complete(bar, b.x, nloc, nx); b.st[0] = nloc; b.st[1] = nx; }
        const unsigned old = xb_add(&bar[XB_XSUB(b.x)], 1u);
        const unsigned gen = old / nloc;
        if (old + 1u == (gen + 1u) * nloc) {
            __builtin_amdgcn_fence(__ATOMIC_RELEASE, "agent");
            asm volatile("s_waitcnt vmcnt(0)" ::: "memory");
            const unsigned og = xb_add(&bar[XB_TOP], 1u);
            const unsigned tg = og / nx;
            if (og + 1u == (tg + 1u) * nx) xb_add(&bar[XB_TOPGEN], 1u);
            else XB_SPIN(xb_ld(&bar[XB_TOPGEN]) == tg, bar);
            __builtin_amdgcn_fence(__ATOMIC_ACQUIRE, "agent");
            xb_add(&bar[XB_XGEN(b.x)], 1u);
            asm volatile("s_waitcnt vmcnt(0)" ::: "memory");
        } else {
            XB_SPIN(xb_ld(&bar[XB_XGEN(b.x)]) == gen, bar);
            __builtin_amdgcn_fence(__ATOMIC_ACQUIRE, "agent");
            asm volatile("s_waitcnt vmcnt(0)" ::: "memory");
        }
    }
    __syncthreads();
}

__device__ __forceinline__ float dpp_xor1(float x) { return __builtin_bit_cast(float, __builtin_amdgcn_update_dpp(0, __builtin_bit_cast(int, x), 0xB1, 0xF, 0xF, true)); }
__device__ __forceinline__ float dpp_xor2(float x) { return __builtin_bit_cast(float, __builtin_amdgcn_update_dpp(0, __builtin_bit_cast(int, x), 0x4E, 0xF, 0xF, true)); }
__device__ __forceinline__ float dpp_hmir(float x) { return __builtin_bit_cast(float, __builtin_amdgcn_update_dpp(0, __builtin_bit_cast(int, x), 0x141, 0xF, 0xF, true)); }
__device__ __forceinline__ float dpp_mir(float x) { return __builtin_bit_cast(float, __builtin_amdgcn_update_dpp(0, __builtin_bit_cast(int, x), 0x140, 0xF, 0xF, true)); }
__device__ __forceinline__ float rdlane(float x, int l) { return __builtin_bit_cast(float, __builtin_amdgcn_readlane(__builtin_bit_cast(int, x), l)); }
__device__ __forceinline__ float wave_sum(float v) {
    v += dpp_xor1(v); v += dpp_xor2(v); v += dpp_hmir(v); v += dpp_mir(v);
    return (rdlane(v, 0) + rdlane(v, 16)) + (rdlane(v, 32) + rdlane(v, 48));
}
__device__ __forceinline__ float quad_sum(float x) { x += dpp_xor1(x); x += dpp_xor2(x); return x; }

__device__ __forceinline__ int opq(int i) { asm volatile("" : "+s"(i)); return i; }
struct Args {
    const float* in[27]; float* out; unsigned char* ws; int ph_lo, ph_hi; int pad0, pad1;
};

__device__ __forceinline__ void transpose_item(const float* W, int ldw, int k0, int n0, bf16* WT, int ldk, int drow0, int kdst0, LAS float* scr, int lane) {
#pragma unroll 8
    for (int i = 0; i < 32; ++i) { const int kk = 2 * i + (lane >> 5); scr[kk * 33 + (lane & 31)] = W[(size_t)(k0 + kk) * ldw + n0 + (lane & 31)]; }
    LDS_WAIT(); asm volatile("" ::: "memory");
    const int c = lane & 7;
#pragma unroll
    for (int j = 0; j < 4; ++j) { const int n = (lane >> 3) + 8 * j; const LAS float* s = scr + (8 * c) * 33 + n;
        v4u o; o.x = pk2(s[0 * 33], s[1 * 33]); o.y = pk2(s[2 * 33], s[3 * 33]); o.z = pk2(s[4 * 33], s[5 * 33]); o.w = pk2(s[6 * 33], s[7 * 33]);
        *(GAS v4u*)(WT + (size_t)(drow0 + n0 + n) * ldk + kdst0 + k0 + 8 * c) = o; }
    LDS_WAIT(); asm volatile("" ::: "memory");
}

__device__ __forceinline__ void rms_row_to_bf16(const float* xrow, const float* g, bf16* orow, int lane) {
    const GAS f32x4* xr = (const GAS f32x4*)xrow + lane; const GAS f32x4* gr = (const GAS f32x4*)g + lane;
    f32x4 v[4]; float s = 0.f;
#pragma unroll
    for (int j = 0; j < 4; ++j) { v[j] = xr[64 * j]; s += (v[j].x * v[j].x + v[j].y * v[j].y) + (v[j].z * v[j].z + v[j].w * v[j].w); }
    const float rs = 1.0f / sqrtf(wave_sum(s) * (1.f / DM) + RMS_EPS);
    GAS v2u* o8 = (GAS v2u*)orow + lane;
#pragma unroll
    for (int j = 0; j < 4; ++j) { const f32x4 gg = gr[64 * j]; v2u o; o.x = pk2(v[j].x * rs * gg.x, v[j].y * rs * gg.y); o.y = pk2(v[j].z * rs * gg.z, v[j].w * rs * gg.w); o8[64 * j] = o; }
}
__device__ __forceinline__ void resid_norm_row(const float* frow, const float* xin, const float* g1, float* xout, const float* g2, bf16* orow, int lane) {
    const GAS f32x4* fr = (const GAS f32x4*)frow + lane; const GAS f32x4* xr = (const GAS f32x4*)xin + lane; const GAS f32x4* g1r = (const GAS f32x4*)g1 + lane;
    f32x4 f[4], x[4]; float s = 0.f;
#pragma unroll
    for (int j = 0; j < 4; ++j) { f[j] = fr[64 * j]; x[j] = xr[64 * j]; s += (f[j].x * f[j].x + f[j].y * f[j].y) + (f[j].z * f[j].z + f[j].w * f[j].w); }
    const float rs = 1.0f / sqrtf(wave_sum(s) * (1.f / DM) + RMS_EPS);
    float s2 = 0.f;
    GAS f32x4* xo = (GAS f32x4*)xout + lane;
#pragma unroll
    for (int j = 0; j < 4; ++j) { const f32x4 gg = g1r[64 * j]; x[j] = x[j] + f[j] * rs * gg; xo[64 * j] = x[j]; s2 += (x[j].x * x[j].x + x[j].y * x[j].y) + (x[j].z * x[j].z + x[j].w * x[j].w); }
    if (g2) {
        const float rs2 = 1.0f / sqrtf(wave_sum(s2) * (1.f / DM) + RMS_EPS);
        const GAS f32x4* g2r = (const GAS f32x4*)g2 + lane; GAS v2u* o8 = (GAS v2u*)orow + lane;
#pragma unroll
        for (int j = 0; j < 4; ++j) { const f32x4 gg = g2r[64 * j]; v2u o; o.x = pk2(x[j].x * rs2 * gg.x, x[j].y * rs2 * gg.y); o.y = pk2(x[j].z * rs2 * gg.z, x[j].w * rs2 * gg.w); o8[64 * j] = o; }
    }
}

__device__ __forceinline__ void row_info(int m, int& pos, int& len, int& sb) { if (m < TP) { pos = m; len = TP; sb = -1; } else { const int r = m - TP; sb = r >> 6; pos = r & 63; len = TS; } }

typedef _Float16 half8 __attribute__((ext_vector_type(8)));
struct ScanCtx {
    const bf16* PR; const float* WD; const _Float16* AL; const _Float16* GO; bf16* YB;
    const float* mu; const float* k_k; const float* k_a; const float* r_k; const float* lnw; const float* lnb;
};
__device__ __forceinline__ float oct_sum(float x) { x += dpp_xor1(x); x += dpp_xor2(x); x += dpp_hmir(x); return x; }
__device__ __forceinline__ void unpack8(const v4u w, float (&f)[8]) {
#pragma unroll
    for (int e = 0; e < 4; ++e) { f[2 * e] = __uint_as_float(w[e] << 16); f[2 * e + 1] = __uint_as_float(w[e] & 0xffff0000u); }
}
template <int KIND>
__device__ __forceinline__ void scan_task(const ScanCtx& C, LAS float* st, int lane_, int h, int m0, int ntok, const float* prev_state  , bool has_prev_row,
                                          const float* S0  , const float* S0T  , void* out0  ) {
    int lane = lane_; asm volatile("" : "+v"(lane));
    const int p = lane >> 2, q = lane & 3, tk = lane >> 3, cg = lane & 7, col8 = 64 * h + 8 * cg;
    LAS float* yb = st + 3072; LAS float* cst = st + 3584;
    f32x4 s[4][4];
#pragma unroll
    for (int r = 0; r < 4; ++r)
#pragma unroll
        for (int i = 0; i < 4; ++i) s[r][i] = (f32x4){0.f, 0.f, 0.f, 0.f};
    if (KIND == 0) {
#pragma unroll
        for (int r = 0; r < 4; ++r)
#pragma unroll
            for (int i = 0; i < 4; ++i)
#pragma unroll
                for (int e = 0; e < 4; ++e) s[r][i][e] = (4 * p + r == 16 * q + 4 * i + e) ? 1.f : 0.f;
    }
    if (KIND == 2) {
        if (S0) {
#pragma unroll
            for (int r = 0; r < 4; ++r)
#pragma unroll
                for (int i = 0; i < 4; ++i) s[r][i] = *(const GAS f32x4*)(S0 + (4 * p + r) * 64 + 16 * q + 4 * i);
        } else if (S0T) {
#pragma unroll
            for (int i = 0; i < 4; ++i)
#pragma unroll
                for (int e = 0; e < 4; ++e) { const f32x4 t = *(const GAS f32x4*)(S0T + (16 * q + 4 * i + e) * 64 + 4 * p);
                    s[0][i][e] = t.x; s[1][i][e] = t.y; s[2][i][e] = t.z; s[3][i][e] = t.w; }
        }
    }
    { const int c = 64 * h + lane;
      cst[lane] = C.mu[c]; cst[64 + lane] = C.mu[512 + c]; cst[128 + lane] = C.mu[1024 + c]; cst[192 + lane] = C.k_k[c]; cst[256 + lane] = C.k_a[c];
      if (KIND == 2) { cst[320 + lane] = C.r_k[c]; cst[384 + lane] = C.lnw[c]; cst[448 + lane] = C.lnb[c]; } }
    LDS_WAIT(); __builtin_amdgcn_wave_barrier(); asm volatile("" ::: "memory");

    for (int t0 = 0; t0 < ntok; t0 += 8) {
        const int m = m0 + t0 + tk;
        const bf16* pp = C.PR + (size_t)m * RWC + col8;
        const bool valid = has_prev_row || (t0 + tk) > 0;
        float ck[8], pk_[8], cr[8], pr_[8], cv[8], pv_[8], al[8];
        float bs = 0.f; v4u gow = (v4u){0u, 0u, 0u, 0u};
        { const v4u wk = *(const GAS v4u*)(pp + 512); unpack8(wk, ck); }
        if (KIND != 0) { const v4u wv = *(const GAS v4u*)(pp + 1024); unpack8(wv, cv); }
        if (KIND == 2) { const v4u wr = *(const GAS v4u*)pp; unpack8(wr, cr); gow = *(const GAS v4u*)(C.GO + (size_t)m * 512 + col8); }
        { const half8 ah = *(const GAS half8*)(C.AL + (size_t)m * 512 + col8);
#pragma unroll
          for (int e = 0; e < 8; ++e) al[e] = (float)ah[e]; }
        const f32x4 wd0 = *(const GAS f32x4*)(C.WD + (size_t)m * 512 + col8), wd1 = *(const GAS f32x4*)(C.WD + (size_t)m * 512 + col8 + 4);
        if (valid) {
            { const v4u wk = *(const GAS v4u*)(pp - RWC + 512); unpack8(wk, pk_); }
            if (KIND != 0) { const v4u wv = *(const GAS v4u*)(pp - RWC + 1024); unpack8(wv, pv_); }
            if (KIND == 2) { const v4u wr = *(const GAS v4u*)(pp - RWC); unpack8(wr, pr_); }
        } else {
#pragma unroll
            for (int e = 0; e < 8; ++e) { pk_[e] = prev_state ? prev_state[512 + col8 + e] : 0.f; pv_[e] = prev_state ? prev_state[1024 + col8 + e] : 0.f; pr_[e] = prev_state ? prev_state[col8 + e] : 0.f; }
        }
        LAS float* o = st + tk * 384 + 8 * cg;
        {
            float kf[8], kk[8]; float n2 = 0.f;
            const f32x4 muk0 = *(const LAS f32x4*)(cst + 64 + 8 * cg), muk1 = *(const LAS f32x4*)(cst + 64 + 8 * cg + 4);
            const f32x4 kc0 = *(const LAS f32x4*)(cst + 192 + 8 * cg), kc1 = *(const LAS f32x4*)(cst + 192 + 8 * cg + 4);
            const f32x4 ka0 = *(const LAS f32x4*)(cst + 256 + 8 * cg), ka1 = *(const LAS f32x4*)(cst + 256 + 8 * cg + 4);
#pragma unroll
            for (int e = 0; e < 8; ++e) { const float muk = e < 4 ? muk0[e & 3] : muk1[e & 3], kc = e < 4 ? kc0[e & 3] : kc1[e & 3], ka = e < 4 ? ka0[e & 3] : ka1[e & 3];
                const float k_ = ck[e] + (pk_[e] - ck[e]) * muk; kk[e] = k_ * kc; n2 += kk[e] * kk[e]; kf[e] = k_ * (1.0f + (al[e] - 1.0f) * ka); }
            n2 = oct_sum(n2);
            const float inv = 1.0f / fmaxf(sqrtf(n2), 1e-12f);
#pragma unroll
            for (int e = 0; e < 8; ++e) kk[e] *= inv;
            *(LAS f32x4*)(o) = wd0; *(LAS f32x4*)(o + 4) = wd1;
            *(LAS f32x4*)(o + 64) = (f32x4){-kk[0], -kk[1], -kk[2], -kk[3]}; *(LAS f32x4*)(o + 68) = (f32x4){-kk[4], -kk[5], -kk[6], -kk[7]};
            *(LAS f32x4*)(o + 128) = (f32x4){kk[0] * al[0], kk[1] * al[1], kk[2] * al[2], kk[3] * al[3]}; *(LAS f32x4*)(o + 132) = (f32x4){kk[4] * al[4], kk[5] * al[5], kk[6] * al[6], kk[7] * al[7]};
            if (KIND != 0) {
                *(LAS f32x4*)(o + 192) = (f32x4){kf[0], kf[1], kf[2], kf[3]}; *(LAS f32x4*)(o + 196) = (f32x4){kf[4], kf[5], kf[6], kf[7]};
                const f32x4 muv0 = *(const LAS f32x4*)(cst + 128 + 8 * cg), muv1 = *(const LAS f32x4*)(cst + 128 + 8 * cg + 4);
                float v_[8];
#pragma unroll
                for (int e = 0; e < 8; ++e) v_[e] = cv[e] + (pv_[e] - cv[e]) * (e < 4 ? muv0[e & 3] : muv1[e & 3]);
                *(LAS f32x4*)(o + 256) = (f32x4){v_[0], v_[1], v_[2], v_[3]}; *(LAS f32x4*)(o + 260) = (f32x4){v_[4], v_[5], v_[6], v_[7]};
            }
            if (KIND == 2) {
                const f32x4 mur0 = *(const LAS f32x4*)(cst + 8 * cg), mur1 = *(const LAS f32x4*)(cst + 8 * cg + 4);
                const f32x4 rk0 = *(const LAS f32x4*)(cst + 320 + 8 * cg), rk1 = *(const LAS f32x4*)(cst + 320 + 8 * cg + 4);
                float r_[8];
#pragma unroll
                for (int e = 0; e < 8; ++e) { r_[e] = cr[e] + (pr_[e] - cr[e]) * (e < 4 ? mur0[e & 3] : mur1[e & 3]); bs += r_[e] * kf[e] * (e < 4 ? rk0[e & 3] : rk1[e & 3]); }
                bs = oct_sum(bs);
                *(LAS f32x4*)(o + 320) = (f32x4){r_[0], r_[1], r_[2], r_[3]}; *(LAS f32x4*)(o + 324) = (f32x4){r_[4], r_[5], r_[6], r_[7]};
            }
        }
        LDS_WAIT(); __builtin_amdgcn_wave_barrier(); asm volatile("" ::: "memory");
#pragma unroll 2
        for (int tb = 0; tb < 8; ++tb) {
            const LAS float* ob = st + tb * 384;
            f32x4 w4[4], a4[4], b4[4], k4[4], r4[4];
#pragma unroll
            for (int i = 0; i < 4; ++i) { w4[i] = *(const LAS f32x4*)(ob + 16 * q + 4 * i); a4[i] = *(const LAS f32x4*)(ob + 64 + 16 * q + 4 * i); b4[i] = *(const LAS f32x4*)(ob + 128 + 16 * q + 4 * i); }
            if (KIND != 0) {
#pragma unroll
                for (int i = 0; i < 4; ++i) k4[i] = *(const LAS f32x4*)(ob + 192 + 16 * q + 4 * i); }
            if (KIND == 2) {
#pragma unroll
                for (int i = 0; i < 4; ++i) r4[i] = *(const LAS f32x4*)(ob + 320 + 16 * q + 4 * i); }
            f32x4 vv = (f32x4){0.f, 0.f, 0.f, 0.f};
            if (KIND != 0) vv = *(const LAS f32x4*)(ob + 256 + 4 * p);
            float sa[4];
#pragma unroll
            for (int r = 0; r < 4; ++r) { f32x4 t = s[r][0] * a4[0]; t += s[r][1] * a4[1]; t += s[r][2] * a4[2]; t += s[r][3] * a4[3]; sa[r] = quad_sum((t.x + t.y) + (t.z + t.w)); }
#pragma unroll
            for (int r = 0; r < 4; ++r)
#pragma unroll
                for (int i = 0; i < 4; ++i) { f32x4 t = s[r][i] * w4[i] + b4[i] * sa[r]; if (KIND != 0) t += k4[i] * vv[r]; s[r][i] = t; }
            if (KIND == 2) {
                float y[4];
#pragma unroll
                for (int r = 0; r < 4; ++r) { f32x4 t = s[r][0] * r4[0]; t += s[r][1] * r4[1]; t += s[r][2] * r4[2]; t += s[r][3] * r4[3]; y[r] = quad_sum((t.x + t.y) + (t.z + t.w)); }
                if (q == 0) *(LAS f32x4*)(yb + tb * 64 + 4 * p) = (f32x4){y[0], y[1], y[2], y[3]};
            }
        }
        if (KIND == 2) {
            LDS_WAIT(); __builtin_amdgcn_wave_barrier(); asm volatile("" ::: "memory");
            const f32x4 y0 = *(const LAS f32x4*)(yb + tk * 64 + 8 * cg), y1 = *(const LAS f32x4*)(yb + tk * 64 + 8 * cg + 4);
            const f32x4 v0 = *(const LAS f32x4*)(o + 256), v1 = *(const LAS f32x4*)(o + 260);
            const f32x4 lw0 = *(const LAS f32x4*)(cst + 384 + 8 * cg), lw1 = *(const LAS f32x4*)(cst + 384 + 8 * cg + 4), lb0 = *(const LAS f32x4*)(cst + 448 + 8 * cg), lb1 = *(const LAS f32x4*)(cst + 448 + 8 * cg + 4);
            float s1 = ((y0.x + y0.y) + (y0.z + y0.w)) + ((y1.x + y1.y) + (y1.z + y1.w));
            float s2 = ((y0.x * y0.x + y0.y * y0.y) + (y0.z * y0.z + y0.w * y0.w)) + ((y1.x * y1.x + y1.y * y1.y) + (y1.z * y1.z + y1.w * y1.w));
            s1 = oct_sum(s1); s2 = oct_sum(s2);
            const float mean = s1 * (1.f / 64.f), var = fmaxf(s2 * (1.f / 64.f) - mean * mean, 0.f), rstd = 1.0f / sqrtf(var + LNX_EPS);
            const half8 gh = __builtin_bit_cast(half8, gow);
            f32x4 o0 = ((y0 - mean) * rstd) * lw0 + lb0 + v0 * bs, o1 = ((y1 - mean) * rstd) * lw1 + lb1 + v1 * bs;
            o0 = o0 * (f32x4){(float)gh[0], (float)gh[1], (float)gh[2], (float)gh[3]}; o1 = o1 * (f32x4){(float)gh[4], (float)gh[5], (float)gh[6], (float)gh[7]};
            v4u ow; ow.x = pk2(o0.x, o0.y); ow.y = pk2(o0.z, o0.w); ow.z = pk2(o1.x, o1.y); ow.w = pk2(o1.z, o1.w);
            *(GAS v4u*)(C.YB + (size_t)m * 512 + col8) = ow;
        }
        LDS_WAIT(); __builtin_amdgcn_wave_barrier(); asm volatile("" ::: "memory");
    }
    if (out0) {
        if (KIND == 0) {
            unsigned char* ob = (unsigned char*)out0;
            const int fb = (((p >> 3) * 2 + ((p >> 2) & 1)) * 2 + (q >> 1)) * 2048 + ((p >> 1) & 1) * 8, lb = ((p & 1) * 32 + 16 * (q & 1)) * 16;
#pragma unroll
            for (int i = 0; i < 4; ++i)
#pragma unroll
                for (int e = 0; e < 4; ++e) { float v[4]; unsigned hb[4];
#pragma unroll
                    for (int r = 0; r < 4; ++r) { v[r] = s[r][i][e]; hb[r] = f2bf(v[r]); v[r] -= __uint_as_float(hb[r] << 16); }
                    v2u hi, lo; hi.x = hb[0] | (hb[1] << 16); hi.y = hb[2] | (hb[3] << 16); lo.x = pk2(v[0], v[1]); lo.y = pk2(v[2], v[3]);
                    unsigned char* d = ob + fb + lb + (4 * i + e) * 16;
                    *(GAS v2u*)d = hi; *(GAS v2u*)(d + 1024) = lo; }
        } else if (KIND == 1) {
            float* of = (float*)out0;
#pragma unroll
            for (int i = 0; i < 4; ++i)
#pragma unroll
                for (int e = 0; e < 4; ++e) *(GAS f32x4*)(of + (16 * q + 4 * i + e) * 64 + 4 * p) = (f32x4){s[0][i][e], s[1][i][e], s[2][i][e], s[3][i][e]};
        } else {
            float* of = (float*)out0;
#pragma unroll
            for (int r = 0; r < 4; ++r)
#pragma unroll
                for (int i = 0; i < 4; ++i) *(GAS f32x4*)(of + (4 * p + r) * 64 + 16 * q + 4 * i) = s[r][i];
        }
    }
}

constexpr int PH_PER_LAYER = 14, N_PHASES = DEPTH * PH_PER_LAYER;

#if MK_PER_PHASE
#define PH_ACTIVE(N) (args.ph_lo == l0 * PH_PER_LAYER + (N))
#define PH_BAR(N)
#else
#define PH_ACTIVE(N) true
#define PH_BAR(N) if (!(l0 == DEPTH - 1 && (N) == PH_PER_LAYER - 1)) xcd_barrier(bar);
#endif
#define PHASE_BEGIN(N) if (PH_ACTIVE(N)) { for (int rep_ = 0; rep_ < ((((REP_MASK) >> (N)) & 1) ? 2 : 1); ++rep_) { const int k = (N); (void)k; \
        unsigned ones_ = ~0u; asm volatile("" : "+s"(ones_)); \
        int lane_id = (int)__builtin_amdgcn_mbcnt_hi(ones_, __builtin_amdgcn_mbcnt_lo(ones_, 0u)); asm volatile("" : "+v"(lane_id)); \
        int bx = bx0, G = G0, wave = wave0, l = l0; asm volatile("" : "+s"(bx), "+s"(G), "+s"(wave), "+s"(l)); \
        const int lane = lane_id, tid = wave * 64 + lane_id, gw = bx * 8 + wave, NGW = G * 8; (void)tid; (void)gw; (void)lane; (void)NGW; \
        size_t zoff = 0; asm volatile("" : "+s"(zoff)); \
        unsigned char* ws = args.ws + zoff; float* out = args.out + zoff; (void)out; (void)ws;
#define PHASE_END(N) } PH_BAR(N) }
__global__ void __launch_bounds__(512, 2) mega(Args args) {
    extern __shared__ __attribute__((aligned(16))) unsigned char lds_raw[];
    LAS unsigned char* lds = (LAS unsigned char*)lds_raw;
    volatile LAS unsigned* MISC = (volatile LAS unsigned*)(lds + MISC_OFF);
    const int G0 = gridDim.x, bx0 = blockIdx.x, wave0 = __builtin_amdgcn_readfirstlane((int)threadIdx.x >> 6);
    for (int u = threadIdx.x; u < (LDS_BYTES - RING_BYTES) / 4; u += 512) ((LAS unsigned*)(lds + RING_BYTES))[u] = 0u;
    __syncthreads();
    XcdBarrier bar; bar.bar = (unsigned*)(args.ws + WS_CTL) + CW_BAR; bar.x = 0; bar.st = nullptr;
    if (!MK_PER_PHASE) bar = xcd_barrier_post((unsigned*)(args.ws + WS_CTL) + CW_BAR, MISC + 8);

#define INP(i) (args.in[opq(i)])
#define WSP(T, off) ((T*)(ws + (off)))
    for (int l0 = 0; l0 < DEPTH; ++l0) {
        PHASE_BEGIN(0)
            const float* w_in = INP(7) + (size_t)l * DM * INC; bf16* WinA = WSP(bf16, W_INA); bf16* WinG = WSP(bf16, W_ING); bf16* Wcr = WSP(bf16, W_CR); bf16* Wo2 = WSP(bf16, W_O2); bf16* XB = WSP(bf16, WS_XB);
            LAS float* scr = (LAS float*)(lds + wave * 16384);
            constexpr int I_IN = 16 * (INC / 32), I_C = 8 * 32, I_O = 16 * 32, NIT = I_IN + 2 * I_C + I_O;
            for (int it = gw; it < NIT; it += NGW) {
                int r = it;
                if (r < I_IN) { const int nb = r % (INC / 32), kb = r / (INC / 32); const int n0 = nb * 32;
                    if (n0 < NCR) transpose_item(w_in, INC, kb * 64, n0, WinA, DM, 0, 0, scr, lane); else transpose_item(w_in + NCR, INC, kb * 64, n0 - NCR, WinG, DM, 0, 0, scr, lane);
                    continue; }
                r -= I_IN;
                if (r < I_C) { transpose_item(INP(20) + (size_t)l * DC * DM, DM, (r / 32) * 64, (r % 32) * 32, Wcr, 512, 0, 0, scr, lane); continue; } r -= I_C;
                if (r < I_C) { transpose_item(INP(21) + (size_t)l * DR * DM, DM, (r / 32) * 64, (r % 32) * 32, Wcr, 512, 1024, 0, scr, lane); continue; } r -= I_C;
                { const float* wo = INP(22) + (size_t)l * DM * DM; transpose_item(wo, DM, (r / 32) * 64, (r % 32) * 32, Wo2, 2048, 0, 0, scr, lane); transpose_item(wo, DM, (r / 32) * 64, (r % 32) * 32, Wo2, 2048, 0, 1024, scr, lane); }
            }
            {
                bf16* WL = WSP(bf16, WS_WL); const float* wd2 = INP(11) + (size_t)l * 64 * 512; const float* a2 = INP(13) + (size_t)l * 64 * 512; const float* g2 = INP(14) + (size_t)l * 128 * 512;
                for (int idx = gw * 64 + lane; idx < 1536 * 32; idx += NGW * 64) {
                    const int n = idx % 1536, o8 = idx / 1536, seg = n >> 9, nn = n & 511, k0 = 8 * o8; float v[8];
#pragma unroll
                    for (int e = 0; e < 8; ++e) { const int kk = k0 + e; v[e] = (seg == 0) ? (kk < 64 ? wd2[(size_t)kk * 512 + nn] : 0.f) : (seg == 1) ? ((kk >= 64 && kk < 128) ? a2[(size_t)(kk - 64) * 512 + nn] : 0.f) : (kk >= 128 ? g2[(size_t)(kk - 128) * 512 + nn] : 0.f); }
                    v4u o; o.x = pk2(v[0], v[1]); o.y = pk2(v[2], v[3]); o.z = pk2(v[4], v[5]); o.w = pk2(v[6], v[7]);
                    *(GAS v4u*)(WL + (size_t)n * 256 + k0) = o;
                }
            }
            if (l == 0) { const float* g = INP(5);
                const float* x_prompt = INP(0); const float* x_sample = INP(1);
                for (int m = gw; m < MT; m += NGW) { const float* xr = (m < TP) ? x_prompt + (size_t)m * DM : x_sample + (size_t)(m - TP) * DM; rms_row_to_bf16(xr, g, XB + (size_t)m * DM, lane); } }
        PHASE_END(0)
        PHASE_BEGIN(1)
            bf16* XB = WSP(bf16, WS_XB); bf16* WinA = WSP(bf16, W_INA); bf16* PC = WSP(bf16, WS_PC); bf16* PR = WSP(bf16, WS_PR);
            pg8::Gemm g{XB, XB, 1 << 30, WinA, DM, DM, DM}; pg8::StaticOrder S; S.init(MT, NCR, G, bx);
            pg8::EpiBf<0> E{PC, 1536, PR, RWC, 1536};
            pg8::gemm_phase<pg8::EpiBf<0>, pg8::StaticOrder, true>(lds, g, S, E, tid);
        PHASE_END(1)
        PHASE_BEGIN(2)
            const bf16* PC = WSP(bf16, WS_PC); const bf16* PR = WSP(bf16, WS_PR); bf16* CA = WSP(bf16, WS_CA);
            const float* cw = INP(9) + (size_t)l * 3 * DC; const float* stc = INP(2) + (size_t)l * NSB * 2 * DC;
            const int c0 = lane * 8;
            float w0[8], w1[8], w2[8];
#pragma unroll
            for (int e = 0; e < 8; ++e) { w0[e] = cw[c0 + e]; w1[e] = cw[512 + c0 + e]; w2[e] = cw[1024 + c0 + e]; }
            bf16* XL = WSP(bf16, WS_XL); const float* mu = INP(8) + (size_t)l * RWC; const float* sts = INP(3) + (size_t)l * NSB * RWC;
            const f32x4 mu4 = *(const GAS f32x4*)(mu + 1536 + 4 * lane);
            for (int m = gw; m < MT; m += NGW) {
                int pos, len, sb; row_info(m, pos, len, sb);
                {
                    const bf16* rp = PR + (size_t)m * RWC + 1536 + 4 * lane; const v2u cw2 = *(const GAS v2u*)rp;
                    float cu[4] = {pg8::bf_lo(cw2.x), pg8::bf_hi(cw2.x), pg8::bf_lo(cw2.y), pg8::bf_hi(cw2.y)}, pv[4];
                    if (pos >= 1) { const v2u pw = *(const GAS v2u*)(rp - RWC); pv[0] = pg8::bf_lo(pw.x); pv[1] = pg8::bf_hi(pw.x); pv[2] = pg8::bf_lo(pw.y); pv[3] = pg8::bf_hi(pw.y); }
                    else if (sb >= 0) { const f32x4 t = *(const GAS f32x4*)(sts + (size_t)sb * RWC + 1536 + 4 * lane); pv[0] = t.x; pv[1] = t.y; pv[2] = t.z; pv[3] = t.w; }
                    else { pv[0] = pv[1] = pv[2] = pv[3] = 0.f; }
#pragma unroll
                    for (int e = 0; e < 4; ++e) { float v = cu[e] + (pv[e] - cu[e]) * mu4[e]; if (lane < 16) v = tanhf(v); else if (lane >= 32) v = sigm(v); cu[e] = v; }
                    v2u xo; xo.x = pk2(cu[0], cu[1]); xo.y = pk2(cu[2], cu[3]); *(GAS v2u*)(XL + (size_t)m * 256 + 4 * lane) = xo;
                }
                float u0[8], u1[8], u2[8], bg[8];
                { const bf16* rp = PC + (size_t)m * 1536; const v4u xi = *(const GAS v4u*)(rp + c0), bb = *(const GAS v4u*)(rp + 512 + c0), cg = *(const GAS v4u*)(rp + 1024 + c0);
#pragma unroll
                  for (int e = 0; e < 4; ++e) { u2[2 * e] = pg8::bf_lo(xi[e]) * pg8::bf_lo(cg[e]); u2[2 * e + 1] = pg8::bf_hi(xi[e]) * pg8::bf_hi(cg[e]); bg[2 * e] = pg8::bf_lo(bb[e]); bg[2 * e + 1] = pg8::bf_hi(bb[e]); } }
                if (pos >= 1) { const bf16* rp = PC + (size_t)(m - 1) * 1536; const v4u xi = *(const GAS v4u*)(rp + c0), cg = *(const GAS v4u*)(rp + 1024 + c0);
#pragma unroll
                  for (int e = 0; e < 4; ++e) { u1[2 * e] = pg8::bf_lo(xi[e]) * pg8::bf_lo(cg[e]); u1[2 * e + 1] = pg8::bf_hi(xi[e]) * pg8::bf_hi(cg[e]); } }
                else {
#pragma unroll
                  for (int e = 0; e < 8; ++e) u1[e] = (sb >= 0) ? stc[(size_t)sb * 1024 + 512 + c0 + e] : 0.f; }
                if (pos >= 2) { const bf16* rp = PC + (size_t)(m - 2) * 1536; const v4u xi = *(const GAS v4u*)(rp + c0), cg = *(const GAS v4u*)(rp + 1024 + c0);
#pragma unroll
                  for (int e = 0; e < 4; ++e) { u0[2 * e] = pg8::bf_lo(xi[e]) * pg8::bf_lo(cg[e]); u0[2 * e + 1] = pg8::bf_hi(xi[e]) * pg8::bf_hi(cg[e]); } }
                else {
#pragma unroll
                  for (int e = 0; e < 8; ++e) u0[e] = (sb >= 0) ? stc[(size_t)sb * 1024 + (size_t)(pos == 1 ? 512 : 0) + c0 + e] : 0.f; }
                v4u o;
                { float y[8];
#pragma unroll
                  for (int e = 0; e < 8; ++e) y[e] = bg[e] * (w0[e] * u0[e] + w1[e] * u1[e] + w2[e] * u2[e]);
                  o.x = pk2(y[0], y[1]); o.y = pk2(y[2], y[3]); o.z = pk2(y[4], y[5]); o.w = pk2(y[6], y[7]); }
                *(GAS v4u*)(CA + (size_t)m * 512 + c0) = o;
                if (pos >= len - 2) {
                    const int j = pos - (len - 2);
                    float* dst = (sb < 0) ? out + O_CONVP + (size_t)l * 1024 + j * 512 + c0 : out + O_CONVS + ((size_t)(l * NSB + sb) * 2 + j) * 512 + c0;
                    *(GAS f32x4*)dst = (f32x4){u2[0], u2[1], u2[2], u2[3]}; *(GAS f32x4*)(dst + 4) = (f32x4){u2[4], u2[5], u2[6], u2[7]};
                    if (pos == len - 1) {
                        float* sd = (sb < 0) ? out + O_SHIFTP + (size_t)l * RWC : out + O_SHIFTS + (size_t)(l * NSB + sb) * RWC; const bf16* rp = PR + (size_t)m * RWC;
                        for (int c = lane; c < RWC; c += 64) sd[c] = bf2f(rp[c]);
                    }
                }
            }
        PHASE_END(2)
        PHASE_BEGIN(3)
            bf16* XL = WSP(bf16, WS_XL); bf16* WL = WSP(bf16, WS_WL);
            int k256 = 256; asm volatile("" : "+s"(k256));
            pg8::Gemm g{XL, XL, 1 << 30, WL, k256, k256, k256}; pg8::StaticOrder S; S.init(MT, 1536, G, bx);
            pg8::EpiLora E{ws, WS_WD, WS_AL, WS_GO, INP(10) + (size_t)l * 512, INP(12) + (size_t)l * 512};
            pg8::gemm_phase<pg8::EpiLora, pg8::StaticOrder, true>(lds, g, S, E, tid);
        PHASE_END(3)
        PHASE_BEGIN(4)
            float* PQ = WSP(float, WS_PQ); float* SS = WSP(float, WS_SS);
            ScanCtx C; C.PR = WSP(bf16, WS_PR); C.WD = WSP(float, WS_WD); C.AL = WSP(_Float16, WS_AL); C.GO = WSP(_Float16, WS_GO); C.YB = WSP(bf16, WS_YB); C.mu = INP(8) + (size_t)l * RWC; C.k_k = INP(15) + (size_t)l * 512; C.k_a = INP(16) + (size_t)l * 512;
            C.r_k = INP(17) + (size_t)l * 512; C.lnw = INP(18) + (size_t)l * 512; C.lnb = INP(19) + (size_t)l * 512;
            LAS float* st = (LAS float*)(lds + wave * 16384);
            if (k == 4) {
                for (int it = gw; it < (NCH - 1) * NH * 2; it += NGW) {
                    const int kind = it & 1, h = (it >> 1) & 7, c = it >> 4;
                    float* o = PQ + ((size_t)(c * NH + h) * 2 + kind) * 4096;
                    if (kind == 0) scan_task<0>(C, st, lane, h, c * CH, CH, nullptr, c > 0, nullptr, nullptr, o);
                    else scan_task<1>(C, st, lane, h, c * CH, CH, nullptr, c > 0, nullptr, nullptr, o);
                }
            } else {
                const float* sts = INP(3) + (size_t)l * NSB * RWC; const float* stw = INP(4) + (size_t)l * NSB * NH * 4096;
                for (int it = gw; it < NCH * NH + NSB * NH; it += NGW) {
                    if (it < NCH * NH) { const int h = it & 7, c = it >> 3;
                        scan_task<2>(C, st, lane, h, c * CH, CH, nullptr, c > 0, nullptr, c > 0 ? SS + (size_t)(c * NH + h) * 4096 : nullptr,
                                     c == NCH - 1 ? out + O_WKVP + (size_t)(l * NH + h) * 4096 : nullptr);
                    } else { const int j = it - NCH * NH, h = j & 7, b = j >> 3;
                        scan_task<2>(C, st, lane, h, TP + 64 * b, TS, sts + (size_t)b * RWC, false, stw + (size_t)(b * NH + h) * 4096, nullptr, out + O_WKVS + (size_t)((l * NSB + b) * NH + h) * 4096);
                    }
                }
            }
        PHASE_END(4)
        PHASE_BEGIN(5)
            if (bx < NH) {
                const int h = bx;
                const unsigned char* PQb = (const unsigned char*)WSP(float, WS_PQ); float* SS = WSP(float, WS_SS);
                LAS unsigned char* RING = lds; LAS unsigned char* BF = lds + 98304;
                const int hh = lane >> 5, mm = lane & 31;
#define S2_UNIT(c) (PQb + (size_t)((c) * NH + h) * 32768)
                if (wave >= 4) {
                    const unsigned wo = (unsigned)(wave - 4) * 4096u;
#define S2_FILL(c) do { const unsigned char* src_ = S2_UNIT(c) + wo + lane * 16; LAS unsigned char* dst_ = RING + ((c) % 3) * 32768 + wo; \
                        _Pragma("unroll") for (int i_ = 0; i_ < 4; ++i_) { \
                            __builtin_amdgcn_global_load_lds((const unsigned*)(src_ + i_ * 1024), (LAS unsigned*)(dst_ + i_ * 1024), 16, 0, 0); \
                            __builtin_amdgcn_global_load_lds((const unsigned*)(src_ + 16384 + i_ * 1024), (LAS unsigned*)(dst_ + 16384 + i_ * 1024), 16, 0, 0); } } while (0)
                    S2_FILL(0); S2_FILL(1);
                    asm volatile("s_waitcnt vmcnt(8)" ::: "memory"); __builtin_amdgcn_s_barrier();
                    for (int c = 0; c < NCH - 1; ++c) {
                        if (c + 2 < NCH - 1) { S2_FILL(c + 2); asm volatile("s_waitcnt vmcnt(8)" ::: "memory"); }
                        else asm volatile("s_waitcnt vmcnt(0)" ::: "memory");
                        __builtin_amdgcn_s_barrier();
                    }
                } else {
                    const int mt = wave >> 1, nt = wave & 1;
                    __builtin_amdgcn_s_barrier();
                    for (int c = 0; c < NCH - 1; ++c) {
                        const LAS unsigned char* slot = RING + (c % 3) * 32768;
                        const LAS float* QTl = (const LAS float*)(slot + 16384);
                        f32x16 d;
#pragma unroll
                        for (int r = 0; r < 16; ++r) d[r] = QTl[(32 * mt + (r & 3) + 8 * (r >> 2) + 4 * hh) * 64 + 32 * nt + mm];
                        if (c > 0) {
#pragma unroll
                            for (int kt = 0; kt < 2; ++kt)
#pragma unroll
                                for (int s = 0; s < 2; ++s) {
                                    const LAS unsigned char* ap = slot + (((kt * 2 + s) * 2 + mt) * 2048) + lane * 16;
                                    const LAS unsigned char* bp = BF + (c & 1) * 16384 + (((kt * 2 + nt) * 2 + s) * 2048) + lane * 16;
                                    const bf16x8 ah = *(const LAS bf16x8*)ap, al = *(const LAS bf16x8*)(ap + 1024), bh = *(const LAS bf16x8*)bp, bl = *(const LAS bf16x8*)(bp + 1024);
                                    d = __builtin_amdgcn_mfma_f32_32x32x16_bf16(ah, bh, d, 0, 0, 0);
                                    d = __builtin_amdgcn_mfma_f32_32x32x16_bf16(al, bh, d, 0, 0, 0);
                                    d = __builtin_amdgcn_mfma_f32_32x32x16_bf16(ah, bl, d, 0, 0, 0);
                                }
                        }
                        float* So = SS + (size_t)((c + 1) * NH + h) * 4096;
#pragma unroll
                        for (int r = 0; r < 16; ++r) So[(32 * mt + (r & 3) + 8 * (r >> 2) + 4 * hh) * 64 + 32 * nt + mm] = d[r];
#pragma unroll
                        for (int s = 0; s < 2; ++s) { unsigned hb[8]; float v[8];
#pragma unroll
                            for (int j = 0; j < 8; ++j) { v[j] = d[8 * s + j]; hb[j] = f2bf(v[j]); v[j] -= __uint_as_float(hb[j] << 16); }
                            v4u hi, lo;
                            hi.x = hb[0] | (hb[1] << 16); hi.y = hb[2] | (hb[3] << 16); hi.z = hb[4] | (hb[5] << 16); hi.w = hb[6] | (hb[7] << 16);
                            lo.x = pk2(v[0], v[1]); lo.y = pk2(v[2], v[3]); lo.z = pk2(v[4], v[5]); lo.w = pk2(v[6], v[7]);
                            LAS unsigned char* dst = BF + ((c + 1) & 1) * 16384 + (((mt * 2 + nt) * 2 + s) * 2048) + lane * 16;
                            *(LAS v4u*)dst = hi; *(LAS v4u*)(dst + 1024) = lo; }
                        LDS_WAIT(); __builtin_amdgcn_s_barrier();
                    }
                }
#undef S2_FILL
#undef S2_UNIT
            }
        PHASE_END(5)
        PHASE_BEGIN(6)
            float* PQ = WSP(float, WS_PQ); float* SS = WSP(float, WS_SS);
            ScanCtx C; C.PR = WSP(bf16, WS_PR); C.WD = WSP(float, WS_WD); C.AL = WSP(_Float16, WS_AL); C.GO = WSP(_Float16, WS_GO); C.YB = WSP(bf16, WS_YB); C.mu = INP(8) + (size_t)l * RWC; C.k_k = INP(15) + (size_t)l * 512; C.k_a = INP(16) + (size_t)l * 512;
            C.r_k = INP(17) + (size_t)l * 512; C.lnw = INP(18) + (size_t)l * 512; C.lnb = INP(19) + (size_t)l * 512;
            LAS float* st = (LAS float*)(lds + wave * 16384);
            if (k == 4) {
                for (int it = gw; it < (NCH - 1) * NH * 2; it += NGW) {
                    const int kind = it & 1, h = (it >> 1) & 7, c = it >> 4;
                    float* o = PQ + ((size_t)(c * NH + h) * 2 + kind) * 4096;
                    if (kind == 0) scan_task<0>(C, st, lane, h, c * CH, CH, nullptr, c > 0, nullptr, nullptr, o);
                    else scan_task<1>(C, st, lane, h, c * CH, CH, nullptr, c > 0, nullptr, nullptr, o);
                }
            } else {
                const float* sts = INP(3) + (size_t)l * NSB * RWC; const float* stw = INP(4) + (size_t)l * NSB * NH * 4096;
                for (int it = gw; it < NCH * NH + NSB * NH; it += NGW) {
                    if (it < NCH * NH) { const int h = it & 7, c = it >> 3;
                        scan_task<2>(C, st, lane, h, c * CH, CH, nullptr, c > 0, nullptr, c > 0 ? SS + (size_t)(c * NH + h) * 4096 : nullptr,
                                     c == NCH - 1 ? out + O_WKVP + (size_t)(l * NH + h) * 4096 : nullptr);
                    } else { const int j = it - NCH * NH, h = j & 7, b = j >> 3;
                        scan_task<2>(C, st, lane, h, TP + 64 * b, TS, sts + (size_t)b * RWC, false, stw + (size_t)(b * NH + h) * 4096, nullptr, out + O_WKVS + (size_t)((l * NSB + b) * NH + h) * 4096);
                    }
                }
            }
        PHASE_END(6)
        PHASE_BEGIN(7)
            bf16* XB = WSP(bf16, WS_XB); bf16* WinG = WSP(bf16, W_ING); bf16* GATES = WSP(bf16, WS_GATES);
            pg8::Gemm g{XB, XB, 1 << 30, WinG, DM, DM, DM}; pg8::StaticOrder S; S.init(MT, NGATE, G, bx);
            pg8::EpiBf<1> E{GATES, 2048, nullptr, 0, 0};
            pg8::gemm_phase<pg8::EpiBf<1>, pg8::StaticOrder, true>(lds, g, S, E, tid);
        PHASE_END(7)
        PHASE_BEGIN(8)
            bf16* CA = WSP(bf16, WS_CA); bf16* YB = WSP(bf16, WS_YB); bf16* Wcr = WSP(bf16, W_CR); bf16* GATES = WSP(bf16, WS_GATES);
            pg8::Gemm g{CA, YB, 4, Wcr, 512, 512, 512}; pg8::StaticOrder S; S.init(MT, 2048, G, bx);
            pg8::EpiBf<2> E{GATES, 2048, nullptr, 0, 0};
            pg8::gemm_phase<pg8::EpiBf<2>, pg8::StaticOrder, true>(lds, g, S, E, tid);
        PHASE_END(8)
        PHASE_BEGIN(9)
            bf16* GATES = WSP(bf16, WS_GATES); bf16* Wo2 = WSP(bf16, W_O2); float* MOUT = WSP(float, WS_MOUT);
            pg8::Gemm g{GATES, GATES, 1 << 30, Wo2, 2048, 2048, 2048}; pg8::StaticOrder S; S.init(MT, DM, G, bx);
            pg8::EpiF32 E{MOUT, DM};
            pg8::gemm_phase<pg8::EpiF32, pg8::StaticOrder, true>(lds, g, S, E, tid);
        PHASE_END(9)
        PHASE_BEGIN(10)
            const float* MOUT = WSP(float, WS_MOUT); bf16* XB = WSP(bf16, WS_XB); bf16* Wup = WSP(bf16, W_UP); bf16* Wdn = WSP(bf16, W_DN); const float* x_prompt = INP(0); const float* x_sample = INP(1);
            const float* g1 = INP(6) + (size_t)l * DM; const float* g2 = INP(23) + (size_t)l * DM;
            for (int m = gw; m < MT; m += NGW) {
                const float* xin = (l == 0) ? ((m < TP) ? x_prompt + (size_t)m * DM : x_sample + (size_t)(m - TP) * DM) : out + (size_t)m * DM;
                resid_norm_row(MOUT + (size_t)m * DM, xin, g1, out + (size_t)m * DM, g2, XB + (size_t)m * DM, lane);
            }
            LAS float* scr = (LAS float*)(lds + wave * 16384);
            const float* wup = INP(25) + (size_t)l * DM * 2 * DFF; const float* wdn = INP(26) + (size_t)l * DFF * DM;
            constexpr int I_UP = 16 * (2 * DFF / 32), I_DN = (DFF / 64) * 32;
            for (int it = gw; it < I_UP + I_DN; it += NGW) {
                if (it < I_UP) { const int nb = it % (2 * DFF / 32), kb = it / (2 * DFF / 32), n0 = nb * 32;
                    const int f = (n0 < DFF) ? n0 : n0 - DFF; const int drow = 256 * (f / 128) + (n0 < DFF ? 0 : 128) + (f % 128);
                    transpose_item(wup + n0, 2 * DFF, kb * 64, 0, Wup, DM, drow, 0, scr, lane);
                } else { const int r = it - I_UP; transpose_item(wdn, DM, (r / 32) * 64, (r % 32) * 32, Wdn, DFF, 0, 0, scr, lane); }
            }
        PHASE_END(10)
        PHASE_BEGIN(11)
            bf16* XB = WSP(bf16, WS_XB); bf16* Wup = WSP(bf16, W_UP); bf16* HB = WSP(bf16, WS_H);
            pg8::Gemm g{XB, XB, 1 << 30, Wup, DM, DM, DM}; pg8::StaticOrder S; S.init(MT, 2 * DFF, G, bx);
            pg8::EpiSwiglu E{HB, DFF};
            pg8::gemm_phase<pg8::EpiSwiglu, pg8::StaticOrder, true>(lds, g, S, E, tid);
        PHASE_END(11)
        PHASE_BEGIN(12)
            bf16* HB = WSP(bf16, WS_H); bf16* Wdn = WSP(bf16, W_DN); float* FOUT = WSP(float, WS_FOUT);
            pg8::Gemm g{HB, HB, 1 << 30, Wdn, DFF, DFF, DFF}; pg8::StaticOrder S; S.init(MT, DM, G, bx);
            pg8::EpiF32 E{FOUT, DM};
            pg8::gemm_phase<pg8::EpiF32, pg8::StaticOrder, true>(lds, g, S, E, tid);
        PHASE_END(12)
        PHASE_BEGIN(13)
            const float* FOUT = WSP(float, WS_FOUT); bf16* XB = WSP(bf16, WS_XB);
            const float* g1 = INP(24) + (size_t)l * DM; const float* g2 = (l + 1 < DEPTH) ? INP(5) + (size_t)(l + 1) * DM : nullptr;
            for (int m = gw; m < MT; m += NGW) resid_norm_row(FOUT + (size_t)m * DM, out + (size_t)m * DM, g1, out + (size_t)m * DM, g2, XB + (size_t)m * DM, lane);
        PHASE_END(13)
    }
}

extern "C" void kernel_launch(void* const* d_in, const int* in_sizes, int n_in, void* d_out, int out_size, void* d_ws, size_t ws_size, hipStream_t stream) {
    static int grid = 0;
    if (grid == 0) {
        if (n_in != 27 || out_size != (int)O_END || ws_size < WS_END) { fprintf(stderr, "kernel_launch: unexpected shapes: n_in %d out %d ws %zu\n", n_in, out_size, ws_size); grid = -1; return; }
        int dev = 0, cus = 0;
        if (hipGetDevice(&dev) != hipSuccess || hipDeviceGetAttribute(&cus, hipDeviceAttributeMultiprocessorCount, dev) != hipSuccess) { grid = -1; return; }
        if (hipFuncSetAttribute((const void*)mega, hipFuncAttributeMaxDynamicSharedMemorySize, LDS_BYTES) != hipSuccess) { fprintf(stderr, "kernel_launch: hipFuncSetAttribute failed\n"); grid = -1; return; }
        (void)hipGetLastError();
        grid = cus;
    }
    if (grid < 0) return;
    (void)hipMemsetAsync((char*)d_ws + WS_CTL, 0, CTL_ZERO_BYTES, stream);
    Args a{};
    for (int i = 0; i < 27; ++i) a.in[i] = (const float*)d_in[i];
    a.out = (float*)d_out; a.ws = (unsigned char*)d_ws;
#if MK_PER_PHASE
    for (int ph = 0; ph < N_PHASES; ++ph) { a.ph_lo = ph; a.ph_hi = ph + 1; hipLaunchKernelGGL(mega, dim3(grid), dim3(512), LDS_BYTES, stream, a); }
#else
    a.ph_lo = 0; a.ph_hi = N_PHASES;
    hipLaunchKernelGGL(mega, dim3(grid), dim3(512), LDS_BYTES, stream, a);
#endif
}
```

```cpp
#include <hip/hip_runtime.h>
#include <cstdio>
#include <cstdint>

#ifndef REP_MASK
#define REP_MASK 0
#endif
#ifndef MK_PER_PHASE
#define MK_PER_PHASE 0
#endif

namespace pg8 {
#define PG8_LAS __attribute__((address_space(3)))
typedef unsigned short bf16_t;
typedef short bf16x8 __attribute__((ext_vector_type(8)));
typedef float f32x4 __attribute__((ext_vector_type(4)));
typedef float f32x2 __attribute__((ext_vector_type(2)));
typedef unsigned u32x4 __attribute__((ext_vector_type(4)));
constexpr int BM = 256, BK = 64, HALF = 128, HTB = HALF * BK * 2, STAGE_BYTES = 8 * HTB, NXCD = 8, WGM = 8;

__host__ __device__ __forceinline__ int lds_byte(int r, int c) { const int st = (r >> 4) * 2 + (c >> 5), rr = r & 15, cc = c & 31, ob = rr * 64 + cc * 2; return st * 1024 + (ob ^ (((ob >> 9) & 1) << 5)); }
__host__ __device__ __forceinline__ void stage_rc(int b, int& R, int& C) { const int st = b / 1024, sb = b % 1024, swz = sb ^ (((sb >> 9) & 1) << 5); R = (st >> 1) * 16 + swz / 64; C = (st & 1) * 32 + (swz % 64) / 2; }
__host__ __device__ __forceinline__ int perm32(int rho) { const int n = rho >> 4, i = rho & 15; return 8 * (i >> 2) + 4 * n + (i & 3); }

struct Unit { int pm, pn; };
struct Gemm { const bf16_t* A0; const bf16_t* A1; int split_pn; const bf16_t* Bt; int lda, ldb, K; };

struct StaticOrder {
    int nM, nN, nwg, G, c;
    __host__ __device__ void init(int M, int N, int G_, int c_) { nM = M / BM; nN = N / BM; nwg = nM * nN; G = G_; c = c_; }
    __host__ __device__ bool next(int i, Unit& u) const {
        const long L = (long)i * G + c; if (L >= nwg) return false;
        int wgid = (int)L; { const int q = nwg / NXCD, r = nwg % NXCD, xcd = wgid % NXCD, off = wgid / NXCD; wgid = (xcd < r ? xcd * (q + 1) : r * (q + 1) + (xcd - r) * q) + off; }
        const int nig = WGM * nN, gid = wgid / nig, fm = gid * WGM, gsz = (nM - fm) < WGM ? (nM - fm) : WGM;
        u.pm = fm + ((wgid % nig) % gsz); u.pn = (wgid % nig) / gsz; return true;
    }
};

__device__ __forceinline__ unsigned cvt_pk_bf16(float lo, float hi) { unsigned r; asm volatile("v_cvt_pk_bf16_f32 %0, %1, %2" : "=v"(r) : "v"(lo), "v"(hi)); return r; }
__device__ __forceinline__ float bf_lo(unsigned w) { return __uint_as_float(w << 16); }
__device__ __forceinline__ float bf_hi(unsigned w) { return __uint_as_float(w & 0xffff0000u); }
__device__ __forceinline__ float sigmoidf_(float x) { return 1.0f / (1.0f + __expf(-x)); }

struct EpiF32 {
    static constexpr bool PERM = false;
    float* C; int ldc;
    __device__ __forceinline__ void operator()(const f32x4 (&acc)[2][2][4][2], const Unit& u, int wr, int wc, int fr, int fq) const {
        const int row0 = u.pm * BM + wr * 64 + fr, col0 = u.pn * BM + wc * 32 + 4 * fq;
#pragma unroll
        for (int ai = 0; ai < 2; ++ai)
#pragma unroll
            for (int m = 0; m < 4; ++m) { float* rowp = C + (size_t)(row0 + ai * HALF + m * 16) * ldc + col0;
#pragma unroll
                for (int bj = 0; bj < 2; ++bj)
#pragma unroll
                    for (int n = 0; n < 2; ++n) *(f32x4*)(rowp + bj * HALF + n * 16) = acc[ai][bj][m][n]; }
    }
};
template <int MODE> struct EpiBf {
    static constexpr bool PERM = true;
    bf16_t* O0; int ld0; bf16_t* O1; int ld1; int split;
    __device__ __forceinline__ void operator()(const f32x4 (&acc)[2][2][4][2], const Unit& u, int wr, int wc, int fr, int fq) const {
        const int row0 = u.pm * BM + wr * 64 + fr; int colt = u.pn * BM; bf16_t* base = O0; int ldc = ld0;
        if (MODE == 0 && colt >= split) { base = O1; ldc = ld1; colt -= split; }
        const int col0 = colt + wc * 32 + 8 * fq;
#pragma unroll
        for (int ai = 0; ai < 2; ++ai)
#pragma unroll
            for (int m = 0; m < 4; ++m) { bf16_t* rowp = base + (size_t)(row0 + ai * HALF + m * 16) * ldc + col0;
#pragma unroll
                for (int bj = 0; bj < 2; ++bj) { f32x4 v0 = acc[ai][bj][m][0], v1 = acc[ai][bj][m][1];
                    if (MODE == 1) {
#pragma unroll
                        for (int e = 0; e < 4; ++e) { v0[e] = sigmoidf_(v0[e]); v1[e] = sigmoidf_(v1[e]); } }
                    if (MODE == 2) { const u32x4 gw = *(const u32x4*)(rowp + bj * HALF);
                        v0[0] *= bf_lo(gw.x); v0[1] *= bf_hi(gw.x); v0[2] *= bf_lo(gw.y); v0[3] *= bf_hi(gw.y);
                        v1[0] *= bf_lo(gw.z); v1[1] *= bf_hi(gw.z); v1[2] *= bf_lo(gw.w); v1[3] *= bf_hi(gw.w); }
                    u32x4 w; w.x = cvt_pk_bf16(v0[0], v0[1]); w.y = cvt_pk_bf16(v0[2], v0[3]); w.z = cvt_pk_bf16(v1[0], v1[1]); w.w = cvt_pk_bf16(v1[2], v1[3]);
                    *(u32x4*)(rowp + bj * HALF) = w; } }
    }
};
struct PairOrder {
    int G, c;
    __host__ __device__ bool next(int i, Unit& u) const {
        const int pr = i >> 1, half = i & 1; const long L = (long)pr * G + c; constexpr int nwg = 288, nM = 72, nN = 4; if (L >= nwg) return false;
        int wgid = (int)L; { const int q = nwg / NXCD, xcd = wgid % NXCD, off = wgid / NXCD; wgid = xcd * q + off; }
        const int nig = WGM * nN, gid = wgid / nig, fm = gid * WGM, gsz = (nM - fm) < WGM ? (nM - fm) : WGM;
        u.pm = fm + ((wgid % nig) % gsz); u.pn = (wgid % nig) / gsz + 4 * half; return true;
    }
};
struct EpiMerge {
    static constexpr bool PERM = true;
    const bf16_t* GT; bf16_t* MG;
    __device__ __forceinline__ void operator()(const f32x4 (&acc)[2][2][4][2], const Unit& u, int wr, int wc, int fr, int fq) const {
        const int row0 = u.pm * BM + wr * 64 + fr, gcol0 = u.pn * BM + wc * 32 + 8 * fq, mcol0 = (u.pn & 3) * BM + wc * 32 + 8 * fq; const bool second = u.pn >= 4;
#pragma unroll
        for (int ai = 0; ai < 2; ++ai)
#pragma unroll
            for (int m = 0; m < 4; ++m) { const size_t row = (size_t)(row0 + ai * HALF + m * 16);
#pragma unroll
                for (int bj = 0; bj < 2; ++bj) { f32x4 v0 = acc[ai][bj][m][0], v1 = acc[ai][bj][m][1];
                    const u32x4 gw = *(const u32x4*)(GT + row * 2048 + gcol0 + bj * HALF); bf16_t* mp = MG + row * 1024 + mcol0 + bj * HALF;
                    v0[0] *= bf_lo(gw.x); v0[1] *= bf_hi(gw.x); v0[2] *= bf_lo(gw.y); v0[3] *= bf_hi(gw.y);
                    v1[0] *= bf_lo(gw.z); v1[1] *= bf_hi(gw.z); v1[2] *= bf_lo(gw.w); v1[3] *= bf_hi(gw.w);
                    if (second) { const u32x4 pw = *(const u32x4*)mp;
                        v0[0] += bf_lo(pw.x); v0[1] += bf_hi(pw.x); v0[2] += bf_lo(pw.y); v0[3] += bf_hi(pw.y);
                        v1[0] += bf_lo(pw.z); v1[1] += bf_hi(pw.z); v1[2] += bf_lo(pw.w); v1[3] += bf_hi(pw.w); }
                    u32x4 w; w.x = cvt_pk_bf16(v0[0], v0[1]); w.y = cvt_pk_bf16(v0[2], v0[3]); w.z = cvt_pk_bf16(v1[0], v1[1]); w.w = cvt_pk_bf16(v1[2], v1[3]);
                    *(u32x4*)mp = w; } }
    }
};
struct EpiSwiglu {
    static constexpr bool PERM = true;
    bf16_t* H; int ldc;
    __device__ __forceinline__ void operator()(const f32x4 (&acc)[2][2][4][2], const Unit& u, int wr, int wc, int fr, int fq) const {
        const int row0 = u.pm * BM + wr * 64 + fr, col0 = u.pn * HALF + wc * 32 + 8 * fq;
#pragma unroll
        for (int ai = 0; ai < 2; ++ai)
#pragma unroll
            for (int m = 0; m < 4; ++m) { bf16_t* rowp = H + (size_t)(row0 + ai * HALF + m * 16) * ldc + col0;
                f32x4 v0 = acc[ai][0][m][0], v1 = acc[ai][0][m][1]; const f32x4 g0 = acc[ai][1][m][0], g1 = acc[ai][1][m][1];
#pragma unroll
                for (int e = 0; e < 4; ++e) { v0[e] = v0[e] * sigmoidf_(v0[e]) * g0[e]; v1[e] = v1[e] * sigmoidf_(v1[e]) * g1[e]; }
                u32x4 w; w.x = cvt_pk_bf16(v0[0], v0[1]); w.y = cvt_pk_bf16(v0[2], v0[3]); w.z = cvt_pk_bf16(v1[0], v1[1]); w.w = cvt_pk_bf16(v1[2], v1[3]);
                *(u32x4*)rowp = w; }
    }
};

typedef _Float16 half8 __attribute__((ext_vector_type(8)));
struct EpiLora {
    static constexpr bool PERM = true;
    unsigned char* ws; size_t owd, oal, ogo; const float* wd0; const float* a0;
    __device__ __forceinline__ void operator()(const f32x4 (&acc)[2][2][4][2], const Unit& u, int wr, int wc, int fr, int fq) const {
        const int row0 = u.pm * BM + wr * 64 + fr, colt = u.pn * BM, seg = colt >> 9, cb = (colt & 511) + wc * 32 + 8 * fq;
        float* WD = (float*)(ws + owd); _Float16* AL = (_Float16*)(ws + oal); _Float16* GO = (_Float16*)(ws + ogo);
#pragma unroll
        for (int bj = 0; bj < 2; ++bj) {
            f32x4 c00 = (f32x4){0.f, 0.f, 0.f, 0.f}, c01 = c00;
            if (seg == 0) { c00 = *(const f32x4*)(wd0 + cb + bj * HALF); c01 = *(const f32x4*)(wd0 + cb + bj * HALF + 4); }
            else if (seg == 1) { c00 = *(const f32x4*)(a0 + cb + bj * HALF); c01 = *(const f32x4*)(a0 + cb + bj * HALF + 4); }
#pragma unroll
            for (int ai = 0; ai < 2; ++ai)
#pragma unroll
                for (int m = 0; m < 4; ++m) { const size_t ro = (size_t)(row0 + ai * HALF + m * 16) * 512 + cb;
                    f32x4 v0 = acc[ai][bj][m][0] + c00, v1 = acc[ai][bj][m][1] + c01;
                    if (seg < 2) {
#pragma unroll
                        for (int e = 0; e < 4; ++e) { v0[e] = sigmoidf_(v0[e]); v1[e] = sigmoidf_(v1[e]); } }
                    if (seg == 0) {
#pragma unroll
                        for (int e = 0; e < 4; ++e) { v0[e] = __expf(-0.60653065971f * v0[e]); v1[e] = __expf(-0.60653065971f * v1[e]); }
                        *(f32x4*)(WD + ro + bj * HALF) = v0; *(f32x4*)(WD + ro + bj * HALF + 4) = v1;
                    } else {
                        half8 hv;
#pragma unroll
                        for (int e = 0; e < 4; ++e) { hv[e] = (_Float16)v0[e]; hv[4 + e] = (_Float16)v1[e]; }
                        *(half8*)((seg == 1 ? AL : GO) + ro + bj * HALF) = hv;
                    }
                    asm volatile("" ::: "memory");
                    {
                    } }
        }
    }
};

template <class Epi, class Sched, bool ALIGN_EPI>
__device__ __forceinline__ void gemm_phase(PG8_LAS unsigned char* lds, const Gemm g, const Sched& S, const Epi& E, const int tid) {
    const int wid = __builtin_amdgcn_readfirstlane(tid >> 6), lane = tid & 63, wr = wid >> 2, wc = wid & 3, fr = lane & 15, fq = lane >> 4;
    const int K = g.K, nt = K / BK;
    unsigned voffA[2], voffB[2];
#pragma unroll
    for (int i = 0; i < 2; ++i) { int R, C; stage_rc(tid * 16 + i * 8192, R, C); const int Rb = Epi::PERM ? ((R & ~31) + perm32(R & 31)) : R;
        voffA[i] = (unsigned)(R * g.lda + C) * 2u; voffB[i] = (unsigned)(Rb * g.ldb + C) * 2u; }
    const size_t kstep = (size_t)(BK * 2);
    const size_t hstepA = (size_t)HALF * g.lda * 2, hstepB = (size_t)HALF * g.ldb * 2;
    const size_t tstepA = 2 * hstepA, tstepB = 2 * hstepB;
    const unsigned ldsw = (unsigned)wid * 1024u;
    const int aoff = lds_byte(wr * 64 + fr, fq * 8), boff = lds_byte(wc * 32 + fr, fq * 8);
#define PG8_SA(b, h) (((b) * 2 + (h)) * HTB)
#define PG8_SB(b, h) ((4 + (b) * 2 + (h)) * HTB)
#define PG8_STAGE(bufoff, gbase, voff) do { _Pragma("unroll") for (int _i = 0; _i < 2; ++_i) \
        __builtin_amdgcn_global_load_lds((const unsigned*)((const char*)(gbase) + (voff)[_i]), (PG8_LAS unsigned*)(lds + (bufoff) + ldsw + _i * 8192), 16, 0, 0); } while (0)
#define PG8_LDA(dst, b, h) do { _Pragma("unroll") for (int m = 0; m < 4; ++m) _Pragma("unroll") for (int k = 0; k < 2; ++k) dst[m][k] = *(const PG8_LAS bf16x8*)(lds + PG8_SA(b, h) + aoff + m * 2048 + k * 1024); } while (0)
#define PG8_LDB(dst, b, h) do { _Pragma("unroll") for (int n = 0; n < 2; ++n) _Pragma("unroll") for (int k = 0; k < 2; ++k) dst[n][k] = *(const PG8_LAS bf16x8*)(lds + PG8_SB(b, h) + boff + n * 2048 + k * 1024); } while (0)
#define PG8_MMA(ai, bj, At, Bt) do { __builtin_amdgcn_s_setprio(1); _Pragma("unroll") for (int m = 0; m < 4; ++m) _Pragma("unroll") for (int n = 0; n < 2; ++n) _Pragma("unroll") for (int k = 0; k < 2; ++k) \
        acc[ai][bj][m][n] = __builtin_amdgcn_mfma_f32_16x16x32_bf16(Bt[n][k], At[m][k], acc[ai][bj][m][n], 0, 0, 0); __builtin_amdgcn_s_setprio(0); } while (0)
#define PG8_WAIT_V(n) asm volatile("s_waitcnt vmcnt(" #n ")" ::: "memory")
#define PG8_WAIT_L(n) asm volatile("s_waitcnt lgkmcnt(" #n ")" ::: "memory")
#define PG8_BAR __builtin_amdgcn_s_barrier()
#define PG8_SCHED __builtin_amdgcn_sched_barrier(0)
#define PG8_APTR(u) ((const char*)((u).pn < g.split_pn ? g.A0 : g.A1) + (size_t)(u).pm * tstepA)
#define PG8_BPTR(u) ((const char*)g.Bt + (size_t)(u).pn * tstepB)
    Unit cur, nxt; int ui = 0;
    if (!S.next(0, cur)) return;
    f32x4 acc[2][2][4][2];
#pragma unroll
    for (int a = 0; a < 2; ++a)
#pragma unroll
        for (int b = 0; b < 2; ++b)
#pragma unroll
            for (int m = 0; m < 4; ++m)
#pragma unroll
                for (int n = 0; n < 2; ++n) acc[a][b][m][n] = (f32x4){0.f, 0.f, 0.f, 0.f};
    bf16x8 At[4][2], B0[2][2], B1[2][2];
    const char* cA = PG8_APTR(cur); const char* cB = PG8_BPTR(cur);
    PG8_STAGE(PG8_SB(0, 0), cB, voffB); PG8_STAGE(PG8_SB(0, 1), cB + hstepB, voffB); PG8_STAGE(PG8_SA(0, 0), cA, voffA); PG8_STAGE(PG8_SA(0, 1), cA + hstepA, voffA);
    if (wr == 1) PG8_BAR;
    PG8_WAIT_V(2); PG8_BAR;
    PG8_STAGE(PG8_SB(1, 0), cB + kstep, voffB); PG8_STAGE(PG8_SA(1, 0), cA + kstep, voffA); PG8_STAGE(PG8_SB(1, 1), cB + hstepB + kstep, voffB);
    PG8_WAIT_V(6); PG8_BAR;
    for (;;) {
        const bool has_next = S.next(ui + 1, nxt);
        const char* nA = has_next ? PG8_APTR(nxt) : cA; const char* nB = has_next ? PG8_BPTR(nxt) : cB;
        for (int t = 0; t < nt; t += 2) {
            const bool last = (t == nt - 2);
            const char* a1 = cA + (size_t)(t + 1) * kstep;
            const char* a2 = last ? nA : cA + (size_t)(t + 2) * kstep; const char* b2 = last ? nB : cB + (size_t)(t + 2) * kstep;
            const char* a3 = a2 + kstep; const char* b3 = b2 + kstep;
            PG8_LDB(B0, 0, 0); PG8_LDB(B1, 0, 1); PG8_SCHED; PG8_LDA(At, 0, 0); PG8_STAGE(PG8_SA(1, 1), a1 + hstepA, voffA);
            PG8_WAIT_V(8); PG8_WAIT_L(0); PG8_BAR; PG8_MMA(0, 0, At, B0); PG8_MMA(0, 1, At, B1); PG8_BAR; PG8_SCHED;
            PG8_LDA(At, 0, 1); PG8_STAGE(PG8_SB(0, 0), b2, voffB); PG8_STAGE(PG8_SB(0, 1), b2 + hstepB, voffB); PG8_STAGE(PG8_SA(0, 0), a2, voffA);
            PG8_WAIT_V(8); PG8_WAIT_L(0); PG8_BAR; PG8_MMA(1, 0, At, B0); PG8_MMA(1, 1, At, B1); PG8_BAR; PG8_SCHED;
            PG8_LDB(B0, 1, 0); PG8_LDB(B1, 1, 1); PG8_SCHED; PG8_LDA(At, 1, 0); PG8_STAGE(PG8_SA(0, 1), a2 + hstepA, voffA);
            PG8_WAIT_V(8); PG8_WAIT_L(0); PG8_BAR; PG8_MMA(0, 0, At, B0); PG8_MMA(0, 1, At, B1); PG8_BAR; PG8_SCHED;
            PG8_LDA(At, 1, 1); PG8_STAGE(PG8_SB(1, 0), b3, voffB); PG8_STAGE(PG8_SB(1, 1), b3 + hstepB, voffB); PG8_STAGE(PG8_SA(1, 0), a3, voffA);
            PG8_WAIT_V(8); PG8_WAIT_L(0); PG8_BAR; PG8_MMA(1, 0, At, B0); PG8_MMA(1, 1, At, B1); PG8_BAR; PG8_SCHED;
        }
        if constexpr (ALIGN_EPI) { if (wr == 0) PG8_BAR; }
        E(acc, cur, wr, wc, fr, fq);
        if (!has_next) break;
#pragma unroll
        for (int a = 0; a < 2; ++a)
#pragma unroll
            for (int b = 0; b < 2; ++b)
#pragma unroll
                for (int m = 0; m < 4; ++m)
#pragma unroll
                    for (int n = 0; n < 2; ++n) acc[a][b][m][n] = (f32x4){0.f, 0.f, 0.f, 0.f};
        cur = nxt; cA = nA; cB = nB; ++ui;
        if constexpr (ALIGN_EPI) { if (wr == 1) PG8_BAR; }
    }
    PG8_WAIT_V(0);
    if constexpr (!ALIGN_EPI) { if (wr == 0) PG8_BAR; }
    PG8_BAR;
#undef PG8_SA
#undef PG8_SB
#undef PG8_STAGE
#undef PG8_LDA
#undef PG8_LDB
#undef PG8_MMA
#undef PG8_WAIT_V
#undef PG8_WAIT_L
#undef PG8_BAR
#undef PG8_SCHED
#undef PG8_APTR
#undef PG8_BPTR
}
}

constexpr int DM = 1024, TP = 16384, NSB = 32, TS = 64, MT = TP + NSB * TS;
constexpr int DEPTH = 2, DC = 512, DR = 512, NH = 8, HS = 64;
constexpr int RWC = 1792, NCR = 3328, NGATE = 2048, INC = 5376, DFF = 2816;
constexpr int CH = 128, NCH = TP / CH;
constexpr float RMS_EPS = 1e-6f, LNX_EPS = 64e-5f;

constexpr size_t MiB = 1u << 20;
constexpr size_t WS_CTL = 0, CTL_ZERO_BYTES = 64 * 1024;
constexpr size_t WS_W = 1 * MiB;
constexpr size_t W_INA = WS_W, W_ING = W_INA + (size_t)NCR * DM * 2, W_CR = W_ING + (size_t)NGATE * DM * 2, W_O2 = W_CR + (size_t)2048 * 512 * 2;
constexpr size_t W_UP = WS_W, W_DN = W_UP + (size_t)2 * DFF * DM * 2;
constexpr size_t WS_SS = 18 * MiB;
constexpr size_t WS_XB = 34 * MiB;
constexpr size_t WS_PC = 70 * MiB;
constexpr size_t WS_WD = 70 * MiB, WS_AL = 106 * MiB;
constexpr size_t WS_PR = 124 * MiB;
constexpr size_t WS_CA = 187 * MiB;
constexpr size_t WS_GO = 205 * MiB;
constexpr size_t WS_PQ = 223 * MiB;
constexpr size_t WS_YB = 223 * MiB;
constexpr size_t WS_XL = 223 * MiB, WS_WL = 233 * MiB;
constexpr size_t WS_GATES = 70 * MiB;
constexpr size_t WS_MERGED = 142 * MiB;
constexpr size_t WS_MOUT = 178 * MiB;
constexpr size_t WS_H = 70 * MiB;
constexpr size_t WS_FOUT = 169 * MiB;
constexpr size_t WS_END = 256 * MiB;
static_assert(W_O2 + (size_t)1024 * 1024 * 2 <= WS_SS && W_DN + (size_t)DM * DFF * 2 <= WS_SS, "weights");
static_assert(WS_SS + (size_t)NCH * NH * 16384 <= WS_XB && WS_XB + (size_t)MT * DM * 2 <= WS_PC && WS_PC + (size_t)MT * 1536 * 2 <= WS_PR && WS_PR + (size_t)MT * RWC * 2 <= WS_CA, "map1");
static_assert(WS_CA + (size_t)MT * 512 * 2 <= WS_GO && WS_GO + (size_t)MT * 512 * 2 <= WS_PQ && WS_PQ + (size_t)NCH * NH * 32768 <= WS_END, "map2");
static_assert(WS_WD + (size_t)MT * 512 * 4 <= WS_AL && WS_AL + (size_t)MT * 512 * 2 <= WS_PR, "map3");
static_assert(WS_GATES + (size_t)MT * 2048 * 2 <= WS_MERGED && WS_MERGED + (size_t)MT * DM * 2 <= WS_MOUT && WS_MOUT + (size_t)MT * DM * 4 <= WS_END && WS_H + (size_t)MT * DFF * 2 <= WS_FOUT && WS_FOUT + (size_t)MT * DM * 4 <= WS_END, "map4");
constexpr int CW_BAR = 4096;

constexpr size_t O_Y = 0, O_CONVP = (size_t)MT * DM, O_SHIFTP = O_CONVP + 2 * 2 * 512, O_WKVP = O_SHIFTP + 2 * RWC, O_CONVS = O_WKVP + 2 * 8 * 4096,
                 O_SHIFTS = O_CONVS + (size_t)2 * 32 * 2 * 512, O_WKVS = O_SHIFTS + (size_t)2 * 32 * RWC, O_END = O_WKVS + (size_t)2 * 32 * 8 * 4096;

constexpr int RING_BYTES = 131072, MISC_OFF = RING_BYTES + 320, LDS_BYTES = 147456;

#define GAS __attribute__((address_space(1)))
#define LAS __attribute__((address_space(3)))
typedef unsigned short bf16;
typedef unsigned v4u __attribute__((ext_vector_type(4)));
typedef unsigned v2u __attribute__((ext_vector_type(2)));
typedef float f32x4 __attribute__((ext_vector_type(4)));
typedef float f32x16 __attribute__((ext_vector_type(16)));
typedef short bf16x8 __attribute__((ext_vector_type(8)));
typedef GAS unsigned gu32;
#define LDS_WAIT() asm volatile("s_waitcnt lgkmcnt(0)" ::: "memory")
#define VM_WAIT() asm volatile("s_waitcnt vmcnt(0)" ::: "memory")
__device__ __forceinline__ unsigned f2bf(float f) { unsigned u = __builtin_bit_cast(unsigned, f); return (u + 0x7fffu + ((u >> 16) & 1u)) >> 16; }
__device__ __forceinline__ unsigned pk2(float lo, float hi) { return f2bf(lo) | (f2bf(hi) << 16); }
__device__ __forceinline__ float bf2f(unsigned short b) { return __uint_as_float((unsigned)b << 16); }
__device__ __forceinline__ float sigm(float x) { return 1.0f / (1.0f + __expf(-x)); }

#define XB_TMO      128
#define XB_XCNT(j)  (256  + 64 * (j))
#define XB_XSUB(j)  (1280 + 64 * (j))
#define XB_XGEN(j)  (2304 + 64 * (j))
#define XB_TOP      3328
#define XB_TOPGEN   3392
#define XCD_BAR_WORDS 3456
#define XB_SPIN_CAP (1u << 18)
__device__ __forceinline__ unsigned xb_ld(unsigned* p)              { return __hip_atomic_load(p, __ATOMIC_RELAXED, __HIP_MEMORY_SCOPE_AGENT); }
__device__ __forceinline__ unsigned xb_add(unsigned* p, unsigned v) { return __hip_atomic_fetch_add(p, v, __ATOMIC_RELAXED, __HIP_MEMORY_SCOPE_AGENT); }
__device__ __forceinline__ unsigned xb_xcc_id() { return (unsigned)__builtin_amdgcn_s_getreg((3 << 11) | 20) & 0xFu; }
#define XB_SPIN(cond, bar) do { unsigned _sp = 0; while (cond) { __builtin_amdgcn_s_sleep(1); \
    if ((++_sp & 255u) == 0u) { if (xb_ld(&(bar)[XB_TMO])) break; if (_sp > XB_SPIN_CAP) { atomicAdd(&(bar)[XB_TMO], 1u); break; } } } } while (0)
struct XcdBarrier { unsigned* bar; unsigned x; volatile LAS unsigned* st; };
__device__ __forceinline__ XcdBarrier xcd_barrier_post(unsigned* bar, volatile LAS unsigned* st) {
    XcdBarrier b; b.bar = bar; b.x = xb_xcc_id(); b.st = st;
    if (threadIdx.x == 0) (void)xb_add(&bar[XB_XCNT(b.x)], 1u);
    return b;
}
__device__ __forceinline__ void xcd_barrier_complete(unsigned* bar, unsigned x, unsigned& nloc, unsigned& nx) {
    const unsigned G = gridDim.x * gridDim.y * gridDim.z;
    unsigned sum, cnt, mine, sp = 0u;
    for (;;) {
        sum = 0u; cnt = 0u; mine = 0u;
#pragma unroll
        for (unsigned j = 0; j < 16; ++j) { const unsigned c = xb_ld(&bar[XB_XCNT(j)]); sum += c; cnt += (c > 0u) ? 1u : 0u; mine = (j == x) ? c : mine; }
        if (sum == G) break;
        __builtin_amdgcn_s_sleep(1);
        if ((++sp & 255u) == 0u) { if (xb_ld(&bar[XB_TMO])) break; if (sp > XB_SPIN_CAP) { atomicAdd(&bar[XB_TMO], 1u); break; } }
    }
    nloc = mine > 0u ? mine : 1u; nx = cnt > 0u ? cnt : 1u;
}
__device__ __forceinline__ void xcd_barrier(const XcdBarrier& b) {
    asm volatile("s_waitcnt vmcnt(0)" ::: "memory");
    __syncthreads();
    if (threadIdx.x == 0) {
        unsigned* bar = b.bar;
        __builtin_amdgcn_s_waitcnt(0);
        unsigned nloc = b.st[0], nx = b.st[1];
        if (nloc == 0u) { xcd_barrier_complete(bar, b.x, nloc, nx); b.st[0] = nloc; b.st[1] = nx; }
        const unsigned old = xb_add(&bar[XB_XSUB(b.x)], 1u);
        const unsigned gen = old / nloc;
        if (old + 1u == (gen + 1u) * nloc) {
            __builtin_amdgcn_fence(__ATOMIC_RELEASE, "agent");
            asm volatile("s_waitcnt vmcnt(0)" ::: "memory");
            const unsigned og = xb_add(&bar[XB_TOP], 1u);
            const unsigned tg = og / nx;
            if (og + 1u == (tg + 1u) * nx) xb_add(&bar[XB_TOPGEN], 1u);
            else XB_SPIN(xb_ld(&bar[XB_TOPGEN]) == tg, bar);
            __builtin_amdgcn_fence(__ATOMIC_ACQUIRE, "agent");
            xb_add(&bar[XB_XGEN(b.x)], 1u);
            asm volatile("s_waitcnt vmcnt(0)" ::: "memory");
        } else {
            XB_SPIN(xb_ld(&bar[XB_XGEN(b.x)]) == gen, bar);
            __builtin_amdgcn_fence(__ATOMIC_ACQUIRE, "agent");
            asm volatile("s_waitcnt vmcnt(0)" ::: "memory");
        }
    }
    __syncthreads();
}

__device__ __forceinline__ float dpp_xor1(float x) { return __builtin_bit_cast(float, __builtin_amdgcn_update_dpp(0, __builtin_bit_cast(int, x), 0xB1, 0xF, 0xF, true)); }
__device__ __forceinline__ float dpp_xor2(float x) { return __builtin_bit_cast(float, __builtin_amdgcn_update_dpp(0, __builtin_bit_cast(int, x), 0x4E, 0xF, 0xF, true)); }
__device__ __forceinline__ float dpp_hmir(float x) { return __builtin_bit_cast(float, __builtin_amdgcn_update_dpp(0, __builtin_bit_cast(int, x), 0x141, 0xF, 0xF, true)); }
__device__ __forceinline__ float dpp_mir(float x) { return __builtin_bit_cast(float, __builtin_amdgcn_update_dpp(0, __builtin_bit_cast(int, x), 0x140, 0xF, 0xF, true)); }
__device__ __forceinline__ float rdlane(float x, int l) { return __builtin_bit_cast(float, __builtin_amdgcn_readlane(__builtin_bit_cast(int, x), l)); }
__device__ __forceinline__ float wave_sum(float v) {
    v += dpp_xor1(v); v += dpp_xor2(v); v += dpp_hmir(v); v += dpp_mir(v);
    return (rdlane(v, 0) + rdlane(v, 16)) + (rdlane(v, 32) + rdlane(v, 48));
}
__device__ __forceinline__ float quad_sum(float x) { x += dpp_xor1(x); x += dpp_xor2(x); return x; }

__device__ __forceinline__ int opq(int i) { asm volatile("" : "+s"(i)); return i; }
struct Args {
    const float* in[27]; float* out; unsigned char* ws; int ph_lo, ph_hi; int pad0, pad1;
};

__device__ __forceinline__ void transpose_item(const float* W, int ldw, int k0, int n0, bf16* WT, int ldk, int drow0, int kdst0, LAS float* scr, int lane) {
#pragma unroll 8
    for (int i = 0; i < 32; ++i) { const int kk = 2 * i + (lane >> 5); scr[kk * 33 + (lane & 31)] = W[(size_t)(k0 + kk) * ldw + n0 + (lane & 31)]; }
    LDS_WAIT(); asm volatile("" ::: "memory");
    const int c = lane & 7;
#pragma unroll
    for (int j = 0; j < 4; ++j) { const int n = (lane >> 3) + 8 * j; const LAS float* s = scr + (8 * c) * 33 + n;
        v4u o; o.x = pk2(s[0 * 33], s[1 * 33]); o.y = pk2(s[2 * 33], s[3 * 33]); o.z = pk2(s[4 * 33], s[5 * 33]); o.w = pk2(s[6 * 33], s[7 * 33]);
        *(GAS v4u*)(WT + (size_t)(drow0 + n0 + n) * ldk + kdst0 + k0 + 8 * c) = o; }
    LDS_WAIT(); asm volatile("" ::: "memory");
}

__device__ __forceinline__ void rms_row_to_bf16(const float* xrow, const float* g, bf16* orow, int lane) {
    const GAS f32x4* xr = (const GAS f32x4*)xrow + lane; const GAS f32x4* gr = (const GAS f32x4*)g + lane;
    f32x4 v[4]; float s = 0.f;
#pragma unroll
    for (int j = 0; j < 4; ++j) { v[j] = xr[64 * j]; s += (v[j].x * v[j].x + v[j].y * v[j].y) + (v[j].z * v[j].z + v[j].w * v[j].w); }
    const float rs = 1.0f / sqrtf(wave_sum(s) * (1.f / DM) + RMS_EPS);
    GAS v2u* o8 = (GAS v2u*)orow + lane;
#pragma unroll
    for (int j = 0; j < 4; ++j) { const f32x4 gg = gr[64 * j]; v2u o; o.x = pk2(v[j].x * rs * gg.x, v[j].y * rs * gg.y); o.y = pk2(v[j].z * rs * gg.z, v[j].w * rs * gg.w); o8[64 * j] = o; }
}
__device__ __forceinline__ void resid_norm_row(const float* frow, const float* xin, const float* g1, float* xout, const float* g2, bf16* orow, int lane) {
    const GAS f32x4* fr = (const GAS f32x4*)frow + lane; const GAS f32x4* xr = (const GAS f32x4*)xin + lane; const GAS f32x4* g1r = (const GAS f32x4*)g1 + lane;
    f32x4 f[4], x[4]; float s = 0.f;
#pragma unroll
    for (int j = 0; j < 4; ++j) { f[j] = fr[64 * j]; x[j] = xr[64 * j]; s += (f[j].x * f[j].x + f[j].y * f[j].y) + (f[j].z * f[j].z + f[j].w * f[j].w); }
    const float rs = 1.0f / sqrtf(wave_sum(s) * (1.f / DM) + RMS_EPS);
    float s2 = 0.f;
    GAS f32x4* xo = (GAS f32x4*)xout + lane;
#pragma unroll
    for (int j = 0; j < 4; ++j) { const f32x4 gg = g1r[64 * j]; x[j] = x[j] + f[j] * rs * gg; xo[64 * j] = x[j]; s2 += (x[j].x * x[j].x + x[j].y * x[j].y) + (x[j].z * x[j].z + x[j].w * x[j].w); }
    if (g2) {
        const float rs2 = 1.0f / sqrtf(wave_sum(s2) * (1.f / DM) + RMS_EPS);
        const GAS f32x4* g2r = (const GAS f32x4*)g2 + lane; GAS v2u* o8 = (GAS v2u*)orow + lane;
#pragma unroll
        for (int j = 0; j < 4; ++j) { const f32x4 gg = g2r[64 * j]; v2u o; o.x = pk2(x[j].x * rs2 * gg.x, x[j].y * rs2 * gg.y); o.y = pk2(x[j].z * rs2 * gg.z, x[j].w * rs2 * gg.w); o8[64 * j] = o; }
    }
}

__device__ __forceinline__ void row_info(int m, int& pos, int& len, int& sb) { if (m < TP) { pos = m; len = TP; sb = -1; } else { const int r = m - TP; sb = r >> 6; pos = r & 63; len = TS; } }

typedef _Float16 half8 __attribute__((ext_vector_type(8)));
struct ScanCtx {
    const bf16* PR; const float* WD; const _Float16* AL; const _Float16* GO; bf16* YB;
    const float* mu; const float* k_k; const float* k_a; const float* r_k; const float* lnw; const float* lnb;
};
__device__ __forceinline__ float oct_sum(float x) { x += dpp_xor1(x); x += dpp_xor2(x); x += dpp_hmir(x); return x; }
__device__ __forceinline__ void unpack8(const v4u w, float (&f)[8]) {
#pragma unroll
    for (int e = 0; e < 4; ++e) { f[2 * e] = __uint_as_float(w[e] << 16); f[2 * e + 1] = __uint_as_float(w[e] & 0xffff0000u); }
}
template <int KIND>
__device__ __forceinline__ void scan_task(const ScanCtx& C, LAS float* st, int lane_, int h, int m0, int ntok, const float* prev_state  , bool has_prev_row,
                                          const float* S0  , const float* S0T  , void* out0  ) {
    int lane = lane_; asm volatile("" : "+v"(lane));
    const int p = lane >> 2, q = lane & 3, tk = lane >> 3, cg = lane & 7, col8 = 64 * h + 8 * cg;
    LAS float* yb = st + 3072; LAS float* cst = st + 3584;
    f32x4 s[4][4];
#pragma unroll
    for (int r = 0; r < 4; ++r)
#pragma unroll
        for (int i = 0; i < 4; ++i) s[r][i] = (f32x4){0.f, 0.f, 0.f, 0.f};
    if (KIND == 0) {
#pragma unroll
        for (int r = 0; r < 4; ++r)
#pragma unroll
            for (int i = 0; i < 4; ++i)
#pragma unroll
                for (int e = 0; e < 4; ++e) s[r][i][e] = (4 * p + r == 16 * q + 4 * i + e) ? 1.f : 0.f;
    }
    if (KIND == 2) {
        if (S0) {
#pragma unroll
            for (int r = 0; r < 4; ++r)
#pragma unroll
                for (int i = 0; i < 4; ++i) s[r][i] = *(const GAS f32x4*)(S0 + (4 * p + r) * 64 + 16 * q + 4 * i);
        } else if (S0T) {
#pragma unroll
            for (int i = 0; i < 4; ++i)
#pragma unroll
                for (int e = 0; e < 4; ++e) { const f32x4 t = *(const GAS f32x4*)(S0T + (16 * q + 4 * i + e) * 64 + 4 * p);
                    s[0][i][e] = t.x; s[1][i][e] = t.y; s[2][i][e] = t.z; s[3][i][e] = t.w; }
        }
    }
    { const int c = 64 * h + lane;
      cst[lane] = C.mu[c]; cst[64 + lane] = C.mu[512 + c]; cst[128 + lane] = C.mu[1024 + c]; cst[192 + lane] = C.k_k[c]; cst[256 + lane] = C.k_a[c];
      if (KIND == 2) { cst[320 + lane] = C.r_k[c]; cst[384 + lane] = C.lnw[c]; cst[448 + lane] = C.lnb[c]; } }
    LDS_WAIT(); __builtin_amdgcn_wave_barrier(); asm volatile("" ::: "memory");

    for (int t0 = 0; t0 < ntok; t0 += 8) {
        const int m = m0 + t0 + tk;
        const bf16* pp = C.PR + (size_t)m * RWC + col8;
        const bool valid = has_prev_row || (t0 + tk) > 0;
        float ck[8], pk_[8], cr[8], pr_[8], cv[8], pv_[8], al[8];
        float bs = 0.f; v4u gow = (v4u){0u, 0u, 0u, 0u};
        { const v4u wk = *(const GAS v4u*)(pp + 512); unpack8(wk, ck); }
        if (KIND != 0) { const v4u wv = *(const GAS v4u*)(pp + 1024); unpack8(wv, cv); }
        if (KIND == 2) { const v4u wr = *(const GAS v4u*)pp; unpack8(wr, cr); gow = *(const GAS v4u*)(C.GO + (size_t)m * 512 + col8); }
        { const half8 ah = *(const GAS half8*)(C.AL + (size_t)m * 512 + col8);
#pragma unroll
          for (int e = 0; e < 8; ++e) al[e] = (float)ah[e]; }
        const f32x4 wd0 = *(const GAS f32x4*)(C.WD + (size_t)m * 512 + col8), wd1 = *(const GAS f32x4*)(C.WD + (size_t)m * 512 + col8 + 4);
        if (valid) {
            { const v4u wk = *(const GAS v4u*)(pp - RWC + 512); unpack8(wk, pk_); }
            if (KIND != 0) { const v4u wv = *(const GAS v4u*)(pp - RWC + 1024); unpack8(wv, pv_); }
            if (KIND == 2) { const v4u wr = *(const GAS v4u*)(pp - RWC); unpack8(wr, pr_); }
        } else {
#pragma unroll
            for (int e = 0; e < 8; ++e) { pk_[e] = prev_state ? prev_state[512 + col8 + e] : 0.f; pv_[e] = prev_state ? prev_state[1024 + col8 + e] : 0.f; pr_[e] = prev_state ? prev_state[col8 + e] : 0.f; }
        }
        LAS float* o = st + tk * 384 + 8 * cg;
        {
            float kf[8], kk[8]; float n2 = 0.f;
            const f32x4 muk0 = *(const LAS f32x4*)(cst + 64 + 8 * cg), muk1 = *(const LAS f32x4*)(cst + 64 + 8 * cg + 4);
            const f32x4 kc0 = *(const LAS f32x4*)(cst + 192 + 8 * cg), kc1 = *(const LAS f32x4*)(cst + 192 + 8 * cg + 4);
            const f32x4 ka0 = *(const LAS f32x4*)(cst + 256 + 8 * cg), ka1 = *(const LAS f32x4*)(cst + 256 + 8 * cg + 4);
#pragma unroll
            for (int e = 0; e < 8; ++e) { const float muk = e < 4 ? muk0[e & 3] : muk1[e & 3], kc = e < 4 ? kc0[e & 3] : kc1[e & 3], ka = e < 4 ? ka0[e & 3] : ka1[e & 3];
                const float k_ = ck[e] + (pk_[e] - ck[e]) * muk; kk[e] = k_ * kc; n2 += kk[e] * kk[e]; kf[e] = k_ * (1.0f + (al[e] - 1.0f) * ka); }
            n2 = oct_sum(n2);
            const float inv = 1.0f / fmaxf(sqrtf(n2), 1e-12f);
#pragma unroll
            for (int e = 0; e < 8; ++e) kk[e] *= inv;
            *(LAS f32x4*)(o) = wd0; *(LAS f32x4*)(o + 4) = wd1;
            *(LAS f32x4*)(o + 64) = (f32x4){-kk[0], -kk[1], -kk[2], -kk[3]}; *(LAS f32x4*)(o + 68) = (f32x4){-kk[4], -kk[5], -kk[6], -kk[7]};
            *(LAS f32x4*)(o + 128) = (f32x4){kk[0] * al[0], kk[1] * al[1], kk[2] * al[2], kk[3] * al[3]}; *(LAS f32x4*)(o + 132) = (f32x4){kk[4] * al[4], kk[5] * al[5], kk[6] * al[6], kk[7] * al[7]};
            if (KIND != 0) {
                *(LAS f32x4*)(o + 192) = (f32x4){kf[0], kf[1], kf[2], kf[3]}; *(LAS f32x4*)(o + 196) = (f32x4){kf[4], kf[5], kf[6], kf[7]};
                const f32x4 muv0 = *(const LAS f32x4*)(cst + 128 + 8 * cg), muv1 = *(const LAS f32x4*)(cst + 128 + 8 * cg + 4);
                float v_[8];
#pragma unroll
                for (int e = 0; e < 8; ++e) v_[e] = cv[e] + (pv_[e] - cv[e]) * (e < 4 ? muv0[e & 3] : muv1[e & 3]);
                *(LAS f32x4*)(o + 256) = (f32x4){v_[0], v_[1], v_[2], v_[3]}; *(LAS f32x4*)(o + 260) = (f32x4){v_[4], v_[5], v_[6], v_[7]};
            }
            if (KIND == 2) {
                const f32x4 mur0 = *(const LAS f32x4*)(cst + 8 * cg), mur1 = *(const LAS f32x4*)(cst + 8 * cg + 4);
                const f32x4 rk0 = *(const LAS f32x4*)(cst + 320 + 8 * cg), rk1 = *(const LAS f32x4*)(cst + 320 + 8 * cg + 4);
                float r_[8];
#pragma unroll
                for (int e = 0; e < 8; ++e) { r_[e] = cr[e] + (pr_[e] - cr[e]) * (e < 4 ? mur0[e & 3] : mur1[e & 3]); bs += r_[e] * kf[e] * (e < 4 ? rk0[e & 3] : rk1[e & 3]); }
                bs = oct_sum(bs);
                *(LAS f32x4*)(o + 320) = (f32x4){r_[0], r_[1], r_[2], r_[3]}; *(LAS f32x4*)(o + 324) = (f32x4){r_[4], r_[5], r_[6], r_[7]};
            }
        }
        LDS_WAIT(); __builtin_amdgcn_wave_barrier(); asm volatile("" ::: "memory");
#pragma unroll 2
        for (int tb = 0; tb < 8; ++tb) {
            const LAS float* ob = st + tb * 384;
            f32x4 w4[4], a4[4], b4[4], k4[4], r4[4];
#pragma unroll
            for (int i = 0; i < 4; ++i) { w4[i] = *(const LAS f32x4*)(ob + 16 * q + 4 * i); a4[i] = *(const LAS f32x4*)(ob + 64 + 16 * q + 4 * i); b4[i] = *(const LAS f32x4*)(ob + 128 + 16 * q + 4 * i); }
            if (KIND != 0) {
#pragma unroll
                for (int i = 0; i < 4; ++i) k4[i] = *(const LAS f32x4*)(ob + 192 + 16 * q + 4 * i); }
            if (KIND == 2) {
#pragma unroll
                for (int i = 0; i < 4; ++i) r4[i] = *(const LAS f32x4*)(ob + 320 + 16 * q + 4 * i); }
            f32x4 vv = (f32x4){0.f, 0.f, 0.f, 0.f};
            if (KIND != 0) vv = *(const LAS f32x4*)(ob + 256 + 4 * p);
            float sa[4];
#pragma unroll
            for (int r = 0; r < 4; ++r) { f32x4 t = s[r][0] * a4[0]; t += s[r][1] * a4[1]; t += s[r][2] * a4[2]; t += s[r][3] * a4[3]; sa[r] = quad_sum((t.x + t.y) + (t.z + t.w)); }
#pragma unroll
            for (int r = 0; r < 4; ++r)
#pragma unroll
                for (int i = 0; i < 4; ++i) { f32x4 t = s[r][i] * w4[i] + b4[i] * sa[r]; if (KIND != 0) t += k4[i] * vv[r]; s[r][i] = t; }
            if (KIND == 2) {
                float y[4];
#pragma unroll
                for (int r = 0; r < 4; ++r) { f32x4 t = s[r][0] * r4[0]; t += s[r][1] * r4[1]; t += s[r][2] * r4[2]; t += s[r][3] * r4[3]; y[r] = quad_sum((t.x + t.y) + (t.z + t.w)); }
                if (q == 0) *(LAS f32x4*)(yb + tb * 64 + 4 * p) = (f32x4){y[0], y[1], y[2], y[3]};
            }
        }
        if (KIND == 2) {
            LDS_WAIT(); __builtin_amdgcn_wave_barrier(); asm volatile("" ::: "memory");
            const f32x4 y0 = *(const LAS f32x4*)(yb + tk * 64 + 8 * cg), y1 = *(const LAS f32x4*)(yb + tk * 64 + 8 * cg + 4);
            const f32x4 v0 = *(const LAS f32x4*)(o + 256), v1 = *(const LAS f32x4*)(o + 260);
            const f32x4 lw0 = *(const LAS f32x4*)(cst + 384 + 8 * cg), lw1 = *(const LAS f32x4*)(cst + 384 + 8 * cg + 4), lb0 = *(const LAS f32x4*)(cst + 448 + 8 * cg), lb1 = *(const LAS f32x4*)(cst + 448 + 8 * cg + 4);
            float s1 = ((y0.x + y0.y) + (y0.z + y0.w)) + ((y1.x + y1.y) + (y1.z + y1.w));
            float s2 = ((y0.x * y0.x + y0.y * y0.y) + (y0.z * y0.z + y0.w * y0.w)) + ((y1.x * y1.x + y1.y * y1.y) + (y1.z * y1.z + y1.w * y1.w));
            s1 = oct_sum(s1); s2 = oct_sum(s2);
            const float mean = s1 * (1.f / 64.f), var = fmaxf(s2 * (1.f / 64.f) - mean * mean, 0.f), rstd = 1.0f / sqrtf(var + LNX_EPS);
            const half8 gh = __builtin_bit_cast(half8, gow);
            f32x4 o0 = ((y0 - mean) * rstd) * lw0 + lb0 + v0 * bs, o1 = ((y1 - mean) * rstd) * lw1 + lb1 + v1 * bs;
            o0 = o0 * (f32x4){(float)gh[0], (float)gh[1], (float)gh[2], (float)gh[3]}; o1 = o1 * (f32x4){(float)gh[4], (float)gh[5], (float)gh[6], (float)gh[7]};
            v4u ow; ow.x = pk2(o0.x, o0.y); ow.y = pk2(o0.z, o0.w); ow.z = pk2(o1.x, o1.y); ow.w = pk2(o1.z, o1.w);
            *(GAS v4u*)(C.YB + (size_t)m * 512 + col8) = ow;
        }
        LDS_WAIT(); __builtin_amdgcn_wave_barrier(); asm volatile("" ::: "memory");
    }
    if (out0) {
        if (KIND == 0) {
            unsigned char* ob = (unsigned char*)out0;
            const int fb = (((p >> 3) * 2 + ((p >> 2) & 1)) * 2 + (q >> 1)) * 2048 + ((p >> 1) & 1) * 8, lb = ((p & 1) * 32 + 16 * (q & 1)) * 16;
#pragma unroll
            for (int i = 0; i < 4; ++i)
#pragma unroll
                for (int e = 0; e < 4; ++e) { float v[4]; unsigned hb[4];
#pragma unroll
                    for (int r = 0; r < 4; ++r) { v[r] = s[r][i][e]; hb[r] = f2bf(v[r]); v[r] -= __uint_as_float(hb[r] << 16); }
                    v2u hi, lo; hi.x = hb[0] | (hb[1] << 16); hi.y = hb[2] | (hb[3] << 16); lo.x = pk2(v[0], v[1]); lo.y = pk2(v[2], v[3]);
                    unsigned char* d = ob + fb + lb + (4 * i + e) * 16;
                    *(GAS v2u*)d = hi; *(GAS v2u*)(d + 1024) = lo; }
        } else if (KIND == 1) {
            float* of = (float*)out0;
#pragma unroll
            for (int i = 0; i < 4; ++i)
#pragma unroll
                for (int e = 0; e < 4; ++e) *(GAS f32x4*)(of + (16 * q + 4 * i + e) * 64 + 4 * p) = (f32x4){s[0][i][e], s[1][i][e], s[2][i][e], s[3][i][e]};
        } else {
            float* of = (float*)out0;
#pragma unroll
            for (int r = 0; r < 4; ++r)
#pragma unroll
                for (int i = 0; i < 4; ++i) *(GAS f32x4*)(of + (4 * p + r) * 64 + 16 * q + 4 * i) = s[r][i];
        }
    }
}

constexpr int PH_PER_LAYER = 14, N_PHASES = DEPTH * PH_PER_LAYER;

#if MK_PER_PHASE
#define PH_ACTIVE(N) (args.ph_lo == l0 * PH_PER_LAYER + (N))
#define PH_BAR(N)
#else
#define PH_ACTIVE(N) true
#define PH_BAR(N) if (!(l0 == DEPTH - 1 && (N) == PH_PER_LAYER - 1)) xcd_barrier(bar);
#endif
#define PHASE_BEGIN(N) if (PH_ACTIVE(N)) { for (int rep_ = 0; rep_ < ((((REP_MASK) >> (N)) & 1) ? 2 : 1); ++rep_) { const int k = (N); (void)k; \
        unsigned ones_ = ~0u; asm volatile("" : "+s"(ones_)); \
        int lane_id = (int)__builtin_amdgcn_mbcnt_hi(ones_, __builtin_amdgcn_mbcnt_lo(ones_, 0u)); asm volatile("" : "+v"(lane_id)); \
        int bx = bx0, G = G0, wave = wave0, l = l0; asm volatile("" : "+s"(bx), "+s"(G), "+s"(wave), "+s"(l)); \
        const int lane = lane_id, tid = wave * 64 + lane_id, gw = bx * 8 + wave, NGW = G * 8; (void)tid; (void)gw; (void)lane; (void)NGW; \
        size_t zoff = 0; asm volatile("" : "+s"(zoff)); \
        unsigned char* ws = args.ws + zoff; float* out = args.out + zoff; (void)out; (void)ws;
#define PHASE_END(N) } PH_BAR(N) }
__global__ void __launch_bounds__(512, 2) mega(Args args) {
    extern __shared__ __attribute__((aligned(16))) unsigned char lds_raw[];
    LAS unsigned char* lds = (LAS unsigned char*)lds_raw;
    volatile LAS unsigned* MISC = (volatile LAS unsigned*)(lds + MISC_OFF);
    const int G0 = gridDim.x, bx0 = blockIdx.x, wave0 = __builtin_amdgcn_readfirstlane((int)threadIdx.x >> 6);
    for (int u = threadIdx.x; u < (LDS_BYTES - RING_BYTES) / 4; u += 512) ((LAS unsigned*)(lds + RING_BYTES))[u] = 0u;
    __syncthreads();
    XcdBarrier bar; bar.bar = (unsigned*)(args.ws + WS_CTL) + CW_BAR; bar.x = 0; bar.st = nullptr;
    if (!MK_PER_PHASE) bar = xcd_barrier_post((unsigned*)(args.ws + WS_CTL) + CW_BAR, MISC + 8);

#define INP(i) (args.in[opq(i)])
#define WSP(T, off) ((T*)(ws + (off)))
    for (int l0 = 0; l0 < DEPTH; ++l0) {
        PHASE_BEGIN(0)
            const float* w_in = INP(7) + (size_t)l * DM * INC; bf16* WinA = WSP(bf16, W_INA); bf16* WinG = WSP(bf16, W_ING); bf16* Wcr = WSP(bf16, W_CR); bf16* Wo2 = WSP(bf16, W_O2); bf16* XB = WSP(bf16, WS_XB);
            LAS float* scr = (LAS float*)(lds + wave * 16384);
            constexpr int I_IN = 16 * (INC / 32), I_C = 8 * 32, I_O = 16 * 32, NIT = I_IN + 2 * I_C + I_O;
            for (int it = gw; it < NIT; it += NGW) {
                int r = it;
                if (r < I_IN) { const int nb = r % (INC / 32), kb = r / (INC / 32); const int n0 = nb * 32;
                    if (n0 < NCR) transpose_item(w_in, INC, kb * 64, n0, WinA, DM, 0, 0, scr, lane); else transpose_item(w_in + NCR, INC, kb * 64, n0 - NCR, WinG, DM, 0, 0, scr, lane);
                    continue; }
                r -= I_IN;
                if (r < I_C) { transpose_item(INP(20) + (size_t)l * DC * DM, DM, (r / 32) * 64, (r % 32) * 32, Wcr, 512, 0, 0, scr, lane); continue; } r -= I_C;
                if (r < I_C) { transpose_item(INP(21) + (size_t)l * DR * DM, DM, (r / 32) * 64, (r % 32) * 32, Wcr, 512, 1024, 0, scr, lane); continue; } r -= I_C;
                { const float* wo = INP(22) + (size_t)l * DM * DM; transpose_item(wo, DM, (r / 32) * 64, (r % 32) * 32, Wo2, DM, 0, 0, scr, lane); }
            }
            {
                bf16* WL = WSP(bf16, WS_WL); const float* wd2 = INP(11) + (size_t)l * 64 * 512; const float* a2 = INP(13) + (size_t)l * 64 * 512; const float* g2 = INP(14) + (size_t)l * 128 * 512;
                for (int idx = gw * 64 + lane; idx < 1536 * 32; idx += NGW * 64) {
                    const int n = idx % 1536, o8 = idx / 1536, seg = n >> 9, nn = n & 511, k0 = 8 * o8; float v[8];
#pragma unroll
                    for (int e = 0; e < 8; ++e) { const int kk = k0 + e; v[e] = (seg == 0) ? (kk < 64 ? wd2[(size_t)kk * 512 + nn] : 0.f) : (seg == 1) ? ((kk >= 64 && kk < 128) ? a2[(size_t)(kk - 64) * 512 + nn] : 0.f) : (kk >= 128 ? g2[(size_t)(kk - 128) * 512 + nn] : 0.f); }
                    v4u o; o.x = pk2(v[0], v[1]); o.y = pk2(v[2], v[3]); o.z = pk2(v[4], v[5]); o.w = pk2(v[6], v[7]);
                    *(GAS v4u*)(WL + (size_t)n * 256 + k0) = o;
                }
            }
            if (l == 0) { const float* g = INP(5);
                const float* x_prompt = INP(0); const float* x_sample = INP(1);
                for (int m = gw; m < MT; m += NGW) { const float* xr = (m < TP) ? x_prompt + (size_t)m * DM : x_sample + (size_t)(m - TP) * DM; rms_row_to_bf16(xr, g, XB + (size_t)m * DM, lane); } }
        PHASE_END(0)
        PHASE_BEGIN(1)
            bf16* XB = WSP(bf16, WS_XB); bf16* WinA = WSP(bf16, W_INA); bf16* PC = WSP(bf16, WS_PC); bf16* PR = WSP(bf16, WS_PR);
            pg8::Gemm g{XB, XB, 1 << 30, WinA, DM, DM, DM}; pg8::StaticOrder S; S.init(MT, NCR, G, bx);
            pg8::EpiBf<0> E{PC, 1536, PR, RWC, 1536};
            pg8::gemm_phase<pg8::EpiBf<0>, pg8::StaticOrder, true>(lds, g, S, E, tid);
        PHASE_END(1)
        PHASE_BEGIN(2)
            const bf16* PC = WSP(bf16, WS_PC); const bf16* PR = WSP(bf16, WS_PR); bf16* CA = WSP(bf16, WS_CA);
            const float* cw = INP(9) + (size_t)l * 3 * DC; const float* stc = INP(2) + (size_t)l * NSB * 2 * DC;
            const int c0 = lane * 8;
            float w0[8], w1[8], w2[8];
#pragma unroll
            for (int e = 0; e < 8; ++e) { w0[e] = cw[c0 + e]; w1[e] = cw[512 + c0 + e]; w2[e] = cw[1024 + c0 + e]; }
            bf16* XL = WSP(bf16, WS_XL); const float* mu = INP(8) + (size_t)l * RWC; const float* sts = INP(3) + (size_t)l * NSB * RWC;
            const f32x4 mu4 = *(const GAS f32x4*)(mu + 1536 + 4 * lane);
            for (int m = gw; m < MT; m += NGW) {
                int pos, len, sb; row_info(m, pos, len, sb);
                {
                    const bf16* rp = PR + (size_t)m * RWC + 1536 + 4 * lane; const v2u cw2 = *(const GAS v2u*)rp;
                    float cu[4] = {pg8::bf_lo(cw2.x), pg8::bf_hi(cw2.x), pg8::bf_lo(cw2.y), pg8::bf_hi(cw2.y)}, pv[4];
                    if (pos >= 1) { const v2u pw = *(const GAS v2u*)(rp - RWC); pv[0] = pg8::bf_lo(pw.x); pv[1] = pg8::bf_hi(pw.x); pv[2] = pg8::bf_lo(pw.y); pv[3] = pg8::bf_hi(pw.y); }
                    else if (sb >= 0) { const f32x4 t = *(const GAS f32x4*)(sts + (size_t)sb * RWC + 1536 + 4 * lane); pv[0] = t.x; pv[1] = t.y; pv[2] = t.z; pv[3] = t.w; }
                    else { pv[0] = pv[1] = pv[2] = pv[3] = 0.f; }
#pragma unroll
                    for (int e = 0; e < 4; ++e) { float v = cu[e] + (pv[e] - cu[e]) * mu4[e]; if (lane < 16) v = tanhf(v); else if (lane >= 32) v = sigm(v); cu[e] = v; }
                    v2u xo; xo.x = pk2(cu[0], cu[1]); xo.y = pk2(cu[2], cu[3]); *(GAS v2u*)(XL + (size_t)m * 256 + 4 * lane) = xo;
                }
                float u0[8], u1[8], u2[8], bg[8];
                { const bf16* rp = PC + (size_t)m * 1536; const v4u xi = *(const GAS v4u*)(rp + c0), bb = *(const GAS v4u*)(rp + 512 + c0), cg = *(const GAS v4u*)(rp + 1024 + c0);
#pragma unroll
                  for (int e = 0; e < 4; ++e) { u2[2 * e] = pg8::bf_lo(xi[e]) * pg8::bf_lo(cg[e]); u2[2 * e + 1] = pg8::bf_hi(xi[e]) * pg8::bf_hi(cg[e]); bg[2 * e] = pg8::bf_lo(bb[e]); bg[2 * e + 1] = pg8::bf_hi(bb[e]); } }
                if (pos >= 1) { const bf16* rp = PC + (size_t)(m - 1) * 1536; const v4u xi = *(const GAS v4u*)(rp + c0), cg = *(const GAS v4u*)(rp + 1024 + c0);
#pragma unroll
                  for (int e = 0; e < 4; ++e) { u1[2 * e] = pg8::bf_lo(xi[e]) * pg8::bf_lo(cg[e]); u1[2 * e + 1] = pg8::bf_hi(xi[e]) * pg8::bf_hi(cg[e]); } }
                else {
#pragma unroll
                  for (int e = 0; e < 8; ++e) u1[e] = (sb >= 0) ? stc[(size_t)sb * 1024 + 512 + c0 + e] : 0.f; }
                if (pos >= 2) { const bf16* rp = PC + (size_t)(m - 2) * 1536; const v4u xi = *(const GAS v4u*)(rp + c0), cg = *(const GAS v4u*)(rp + 1024 + c0);
#pragma unroll
                  for (int e = 0; e < 4; ++e) { u0[2 * e] = pg8::bf_lo(xi[e]) * pg8::bf_lo(cg[e]); u0[2 * e + 1] = pg8::bf_hi(xi[e]) * pg8::bf_hi(cg[e]); } }
                else {
#pragma unroll
                  for (int e = 0; e < 8; ++e) u0[e] = (sb >= 0) ? stc[(size_t)sb * 1024 + (size_t)(pos == 1 ? 512 : 0) + c0 + e] : 0.f; }
                v4u o;
                { float y[8];
#pragma unroll
                  for (int e = 0; e < 8; ++e) y[e] = bg[e] * (w0[e] * u0[e] + w1[e] * u1[e] + w2[e] * u2[e]);
                  o.x = pk2(y[0], y[1]); o.y = pk2(y[2], y[3]); o.z = pk2(y[4], y[5]); o.w = pk2(y[6], y[7]); }
                *(GAS v4u*)(CA + (size_t)m * 512 + c0) = o;
                if (pos >= len - 2) {
                    const int j = pos - (len - 2);
                    float* dst = (sb < 0) ? out + O_CONVP + (size_t)l * 1024 + j * 512 + c0 : out + O_CONVS + ((size_t)(l * NSB + sb) * 2 + j) * 512 + c0;
                    *(GAS f32x4*)dst = (f32x4){u2[0], u2[1], u2[2], u2[3]}; *(GAS f32x4*)(dst + 4) = (f32x4){u2[4], u2[5], u2[6], u2[7]};
                    if (pos == len - 1) {
                        float* sd = (sb < 0) ? out + O_SHIFTP + (size_t)l * RWC : out + O_SHIFTS + (size_t)(l * NSB + sb) * RWC; const bf16* rp = PR + (size_t)m * RWC;
                        for (int c = lane; c < RWC; c += 64) sd[c] = bf2f(rp[c]);
                    }
                }
            }
        PHASE_END(2)
        PHASE_BEGIN(3)
            bf16* XL = WSP(bf16, WS_XL); bf16* WL = WSP(bf16, WS_WL);
            int k256 = 256; asm volatile("" : "+s"(k256));
            pg8::Gemm g{XL, XL, 1 << 30, WL, k256, k256, k256}; pg8::StaticOrder S; S.init(MT, 1536, G, bx);
            pg8::EpiLora E{ws, WS_WD, WS_AL, WS_GO, INP(10) + (size_t)l * 512, INP(12) + (size_t)l * 512};
            pg8::gemm_phase<pg8::EpiLora, pg8::StaticOrder, true>(lds, g, S, E, tid);
        PHASE_END(3)
        PHASE_BEGIN(4)
            float* PQ = WSP(float, WS_PQ); float* SS = WSP(float, WS_SS);
            ScanCtx C; C.PR = WSP(bf16, WS_PR); C.WD = WSP(float, WS_WD); C.AL = WSP(_Float16, WS_AL); C.GO = WSP(_Float16, WS_GO); C.YB = WSP(bf16, WS_YB); C.mu = INP(8) + (size_t)l * RWC; C.k_k = INP(15) + (size_t)l * 512; C.k_a = INP(16) + (size_t)l * 512;
            C.r_k = INP(17) + (size_t)l * 512; C.lnw = INP(18) + (size_t)l * 512; C.lnb = INP(19) + (size_t)l * 512;
            LAS float* st = (LAS float*)(lds + wave * 16384);
            if (k == 4) {
                for (int u2 = (wave & 3) * G + bx; u2 < (NCH - 1) * NH; u2 += 4 * G) {
                    const int kind = wave >> 2, h = u2 & 7, c = u2 >> 3;
                    float* o = PQ + ((size_t)(c * NH + h) * 2 + kind) * 4096;
                    if (kind == 0) scan_task<0>(C, st, lane, h, c * CH, CH, nullptr, c > 0, nullptr, nullptr, o);
                    else scan_task<1>(C, st, lane, h, c * CH, CH, nullptr, c > 0, nullptr, nullptr, o);
                }
            } else {
                const float* sts = INP(3) + (size_t)l * NSB * RWC; const float* stw = INP(4) + (size_t)l * NSB * NH * 4096;
                for (int it = (wave < 4 ? wave * G + bx : (wave == 4 ? NCH * NH + bx : (1 << 30))); it < NCH * NH + NSB * NH; it += (wave < 4 ? 4 * G : G)) {
                    if (wave < 4 && it >= NCH * NH) break;
                    if (it < NCH * NH) { const int h = it & 7, c = it >> 3;
                        scan_task<2>(C, st, lane, h, c * CH, CH, nullptr, c > 0, nullptr, c > 0 ? SS + (size_t)(c * NH + h) * 4096 : nullptr,
                                     c == NCH - 1 ? out + O_WKVP + (size_t)(l * NH + h) * 4096 : nullptr);
                    } else { const int j = it - NCH * NH, h = j & 7, b = j >> 3;
                        scan_task<2>(C, st, lane, h, TP + 64 * b, TS, sts + (size_t)b * RWC, false, stw + (size_t)(b * NH + h) * 4096, nullptr, out + O_WKVS + (size_t)((l * NSB + b) * NH + h) * 4096);
                    }
                }
            }
        PHASE_END(4)
        PHASE_BEGIN(5)
            if (bx < NH) {
                const int h = bx;
                const unsigned char* PQb = (const unsigned char*)WSP(float, WS_PQ); float* SS = WSP(float, WS_SS);
                LAS unsigned char* RING = lds; LAS unsigned char* BF = lds + 98304;
                const int hh = lane >> 5, mm = lane & 31;
#define S2_UNIT(c) (PQb + (size_t)((c) * NH + h) * 32768)
                if (wave >= 4) {
                    const unsigned wo = (unsigned)(wave - 4) * 4096u;
#define S2_FILL(c) do { const unsigned char* src_ = S2_UNIT(c) + wo + lane * 16; LAS unsigned char* dst_ = RING + ((c) % 3) * 32768 + wo; \
                        _Pragma("unroll") for (int i_ = 0; i_ < 4; ++i_) { \
                            __builtin_amdgcn_global_load_lds((const unsigned*)(src_ + i_ * 1024), (LAS unsigned*)(dst_ + i_ * 1024), 16, 0, 0); \
                            __builtin_amdgcn_global_load_lds((const unsigned*)(src_ + 16384 + i_ * 1024), (LAS unsigned*)(dst_ + 16384 + i_ * 1024), 16, 0, 0); } } while (0)
                    S2_FILL(0); S2_FILL(1);
                    asm volatile("s_waitcnt vmcnt(8)" ::: "memory"); __builtin_amdgcn_s_barrier();
                    for (int c = 0; c < NCH - 1; ++c) {
                        if (c + 2 < NCH - 1) { S2_FILL(c + 2); asm volatile("s_waitcnt vmcnt(8)" ::: "memory"); }
                        else asm volatile("s_waitcnt vmcnt(0)" ::: "memory");
                        __builtin_amdgcn_s_barrier();
                    }
                } else {
                    const int mt = wave >> 1, nt = wave & 1;
                    __builtin_amdgcn_s_barrier();
                    for (int c = 0; c < NCH - 1; ++c) {
                        const LAS unsigned char* slot = RING + (c % 3) * 32768;
                        const LAS float* QTl = (const LAS float*)(slot + 16384);
                        f32x16 d;
#pragma unroll
                        for (int r = 0; r < 16; ++r) d[r] = QTl[(32 * mt + (r & 3) + 8 * (r >> 2) + 4 * hh) * 64 + 32 * nt + mm];
                        if (c > 0) {
#pragma unroll
                            for (int kt = 0; kt < 2; ++kt)
#pragma unroll
                                for (int s = 0; s < 2; ++s) {
                                    const LAS unsigned char* ap = slot + (((kt * 2 + s) * 2 + mt) * 2048) + lane * 16;
                                    const LAS unsigned char* bp = BF + (c & 1) * 16384 + (((kt * 2 + nt) * 2 + s) * 2048) + lane * 16;
                                    const bf16x8 ah = *(const LAS bf16x8*)ap, al = *(const LAS bf16x8*)(ap + 1024), bh = *(const LAS bf16x8*)bp, bl = *(const LAS bf16x8*)(bp + 1024);
                                    d = __builtin_amdgcn_mfma_f32_32x32x16_bf16(ah, bh, d, 0, 0, 0);
                                    d = __builtin_amdgcn_mfma_f32_32x32x16_bf16(al, bh, d, 0, 0, 0);
                                    d = __builtin_amdgcn_mfma_f32_32x32x16_bf16(ah, bl, d, 0, 0, 0);
                                }
                        }
                        float* So = SS + (size_t)((c + 1) * NH + h) * 4096;
#pragma unroll
                        for (int r = 0; r < 16; ++r) So[(32 * mt + (r & 3) + 8 * (r >> 2) + 4 * hh) * 64 + 32 * nt + mm] = d[r];
#pragma unroll
                        for (int s = 0; s < 2; ++s) { unsigned hb[8]; float v[8];
#pragma unroll
                            for (int j = 0; j < 8; ++j) { v[j] = d[8 * s + j]; hb[j] = f2bf(v[j]); v[j] -= __uint_as_float(hb[j] << 16); }
                            v4u hi, lo;
                            hi.x = hb[0] | (hb[1] << 16); hi.y = hb[2] | (hb[3] << 16); hi.z = hb[4] | (hb[5] << 16); hi.w = hb[6] | (hb[7] << 16);
                            lo.x = pk2(v[0], v[1]); lo.y = pk2(v[2], v[3]); lo.z = pk2(v[4], v[5]); lo.w = pk2(v[6], v[7]);
                            LAS unsigned char* dst = BF + ((c + 1) & 1) * 16384 + (((mt * 2 + nt) * 2 + s) * 2048) + lane * 16;
                            *(LAS v4u*)dst = hi; *(LAS v4u*)(dst + 1024) = lo; }
                        LDS_WAIT(); __builtin_amdgcn_s_barrier();
                    }
                }
#undef S2_FILL
#undef S2_UNIT
            }
        PHASE_END(5)
        PHASE_BEGIN(6)
            float* PQ = WSP(float, WS_PQ); float* SS = WSP(float, WS_SS);
            ScanCtx C; C.PR = WSP(bf16, WS_PR); C.WD = WSP(float, WS_WD); C.AL = WSP(_Float16, WS_AL); C.GO = WSP(_Float16, WS_GO); C.YB = WSP(bf16, WS_YB); C.mu = INP(8) + (size_t)l * RWC; C.k_k = INP(15) + (size_t)l * 512; C.k_a = INP(16) + (size_t)l * 512;
            C.r_k = INP(17) + (size_t)l * 512; C.lnw = INP(18) + (size_t)l * 512; C.lnb = INP(19) + (size_t)l * 512;
            LAS float* st = (LAS float*)(lds + wave * 16384);
            if (k == 4) {
                for (int u2 = (wave & 3) * G + bx; u2 < (NCH - 1) * NH; u2 += 4 * G) {
                    const int kind = wave >> 2, h = u2 & 7, c = u2 >> 3;
                    float* o = PQ + ((size_t)(c * NH + h) * 2 + kind) * 4096;
                    if (kind == 0) scan_task<0>(C, st, lane, h, c * CH, CH, nullptr, c > 0, nullptr, nullptr, o);
                    else scan_task<1>(C, st, lane, h, c * CH, CH, nullptr, c > 0, nullptr, nullptr, o);
                }
            } else {
                const float* sts = INP(3) + (size_t)l * NSB * RWC; const float* stw = INP(4) + (size_t)l * NSB * NH * 4096;
                for (int it = (wave < 4 ? wave * G + bx : (wave == 4 ? NCH * NH + bx : (1 << 30))); it < NCH * NH + NSB * NH; it += (wave < 4 ? 4 * G : G)) {
                    if (wave < 4 && it >= NCH * NH) break;
                    if (it < NCH * NH) { const int h = it & 7, c = it >> 3;
                        scan_task<2>(C, st, lane, h, c * CH, CH, nullptr, c > 0, nullptr, c > 0 ? SS + (size_t)(c * NH + h) * 4096 : nullptr,
                                     c == NCH - 1 ? out + O_WKVP + (size_t)(l * NH + h) * 4096 : nullptr);
                    } else { const int j = it - NCH * NH, h = j & 7, b = j >> 3;
                        scan_task<2>(C, st, lane, h, TP + 64 * b, TS, sts + (size_t)b * RWC, false, stw + (size_t)(b * NH + h) * 4096, nullptr, out + O_WKVS + (size_t)((l * NSB + b) * NH + h) * 4096);
                    }
                }
            }
        PHASE_END(6)
        PHASE_BEGIN(7)
            bf16* XB = WSP(bf16, WS_XB); bf16* WinG = WSP(bf16, W_ING); bf16* GATES = WSP(bf16, WS_GATES);
            pg8::Gemm g{XB, XB, 1 << 30, WinG, DM, DM, DM}; pg8::StaticOrder S; S.init(MT, NGATE, G, bx);
            pg8::EpiBf<1> E{GATES, 2048, nullptr, 0, 0};
            pg8::gemm_phase<pg8::EpiBf<1>, pg8::StaticOrder, true>(lds, g, S, E, tid);
        PHASE_END(7)
        PHASE_BEGIN(8)
            bf16* CA = WSP(bf16, WS_CA); bf16* YB = WSP(bf16, WS_YB); bf16* Wcr = WSP(bf16, W_CR);
            pg8::Gemm g{CA, YB, 4, Wcr, 512, 512, 512}; pg8::PairOrder S{G, bx};
            pg8::EpiMerge E{WSP(bf16, WS_GATES), WSP(bf16, WS_MERGED)};
            pg8::gemm_phase<pg8::EpiMerge, pg8::PairOrder, true>(lds, g, S, E, tid);
        PHASE_END(8)
        PHASE_BEGIN(9)
            bf16* MERGED = WSP(bf16, WS_MERGED); bf16* Wo2 = WSP(bf16, W_O2); float* MOUT = WSP(float, WS_MOUT);
            pg8::Gemm g{MERGED, MERGED, 1 << 30, Wo2, DM, DM, DM}; pg8::StaticOrder S; S.init(MT, DM, G, bx);
            pg8::EpiF32 E{MOUT, DM};
            pg8::gemm_phase<pg8::EpiF32, pg8::StaticOrder, true>(lds, g, S, E, tid);
        PHASE_END(9)
        PHASE_BEGIN(10)
            const float* MOUT = WSP(float, WS_MOUT); bf16* XB = WSP(bf16, WS_XB); bf16* Wup = WSP(bf16, W_UP); bf16* Wdn = WSP(bf16, W_DN); const float* x_prompt = INP(0); const float* x_sample = INP(1);
            const float* g1 = INP(6) + (size_t)l * DM; const float* g2 = INP(23) + (size_t)l * DM;
            for (int m = gw; m < MT; m += NGW) {
                const float* xin = (l == 0) ? ((m < TP) ? x_prompt + (size_t)m * DM : x_sample + (size_t)(m - TP) * DM) : out + (size_t)m * DM;
                resid_norm_row(MOUT + (size_t)m * DM, xin, g1, out + (size_t)m * DM, g2, XB + (size_t)m * DM, lane);
            }
            LAS float* scr = (LAS float*)(lds + wave * 16384);
            const float* wup = INP(25) + (size_t)l * DM * 2 * DFF; const float* wdn = INP(26) + (size_t)l * DFF * DM;
            constexpr int I_UP = 16 * (2 * DFF / 32), I_DN = (DFF / 64) * 32;
            for (int it = gw; it < I_UP + I_DN; it += NGW) {
                if (it < I_UP) { const int nb = it % (2 * DFF / 32), kb = it / (2 * DFF / 32), n0 = nb * 32;
                    const int f = (n0 < DFF) ? n0 : n0 - DFF; const int drow = 256 * (f / 128) + (n0 < DFF ? 0 : 128) + (f % 128);
                    transpose_item(wup + n0, 2 * DFF, kb * 64, 0, Wup, DM, drow, 0, scr, lane);
                } else { const int r = it - I_UP; transpose_item(wdn, DM, (r / 32) * 64, (r % 32) * 32, Wdn, DFF, 0, 0, scr, lane); }
            }
        PHASE_END(10)
        PHASE_BEGIN(11)
            bf16* XB = WSP(bf16, WS_XB); bf16* Wup = WSP(bf16, W_UP); bf16* HB = WSP(bf16, WS_H);
            pg8::Gemm g{XB, XB, 1 << 30, Wup, DM, DM, DM}; pg8::StaticOrder S; S.init(MT, 2 * DFF, G, bx);
            pg8::EpiSwiglu E{HB, DFF};
            pg8::gemm_phase<pg8::EpiSwiglu, pg8::StaticOrder, true>(lds, g, S, E, tid);
        PHASE_END(11)
        PHASE_BEGIN(12)
            bf16* HB = WSP(bf16, WS_H); bf16* Wdn = WSP(bf16, W_DN); float* FOUT = WSP(float, WS_FOUT);
            pg8::Gemm g{HB, HB, 1 << 30, Wdn, DFF, DFF, DFF}; pg8::StaticOrder S; S.init(MT, DM, G, bx);
            pg8::EpiF32 E{FOUT, DM};
            pg8::gemm_phase<pg8::EpiF32, pg8::StaticOrder, true>(lds, g, S, E, tid);
        PHASE_END(12)
        PHASE_BEGIN(13)
            const float* FOUT = WSP(float, WS_FOUT); bf16* XB = WSP(bf16, WS_XB);
            const float* g1 = INP(24) + (size_t)l * DM; const float* g2 = (l + 1 < DEPTH) ? INP(5) + (size_t)(l + 1) * DM : nullptr;
            for (int m = gw; m < MT; m += NGW) resid_norm_row(FOUT + (size_t)m * DM, out + (size_t)m * DM, g1, out + (size_t)m * DM, g2, XB + (size_t)m * DM, lane);
        PHASE_END(13)
    }
}

extern "C" void kernel_launch(void* const* d_in, const int* in_sizes, int n_in, void* d_out, int out_size, void* d_ws, size_t ws_size, hipStream_t stream) {
    static int grid = 0;
    if (grid == 0) {
        if (n_in != 27 || out_size != (int)O_END || ws_size < WS_END) { fprintf(stderr, "kernel_launch: unexpected shapes: n_in %d out %d ws %zu\n", n_in, out_size, ws_size); grid = -1; return; }
        int dev = 0, cus = 0;
        if (hipGetDevice(&dev) != hipSuccess || hipDeviceGetAttribute(&cus, hipDeviceAttributeMultiprocessorCount, dev) != hipSuccess) { grid = -1; return; }
        if (hipFuncSetAttribute((const void*)mega, hipFuncAttributeMaxDynamicSharedMemorySize, LDS_BYTES) != hipSuccess) { fprintf(stderr, "kernel_launch: hipFuncSetAttribute failed\n"); grid = -1; return; }
        (void)hipGetLastError();
        grid = cus;
    }
    if (grid < 0) return;
    (void)hipMemsetAsync((char*)d_ws + WS_CTL, 0, CTL_ZERO_BYTES, stream);
    Args a{};
    for (int i = 0; i < 27; ++i) a.in[i] = (const float*)d_in[i];
    a.out = (float*)d_out; a.ws = (unsigned char*)d_ws;
#if MK_PER_PHASE
    for (int ph = 0; ph < N_PHASES; ++ph) { a.ph_lo = ph; a.ph_hi = ph + 1; hipLaunchKernelGGL(mega, dim3(grid), dim3(512), LDS_BYTES, stream, a); }
#else
    a.ph_lo = 0; a.ph_hi = N_PHASES;
    hipLaunchKernelGGL(mega, dim3(grid), dim3(512), LDS_BYTES, stream, a);
#endif
}
```
